# Optimizing an MI355X kernel written in HIP

```python
import jax, jax.numpy as jnp
from jax import lax
import numpy as np

D_MODEL = 1024
BATCH = 8
SEQ = 2048
DEPTH = 4

SB_HEADS = 8
SB_HEAD_DIM = 64
SB_WIDTH = SB_HEADS * SB_HEAD_DIM
MLA_HEADS = 8
MLA_NOPE_DIM = 64
MLA_ROPE_DIM = 32
MLA_V_DIM = 64
MLA_QK_DIM = MLA_NOPE_DIM + MLA_ROPE_DIM
MLA_Q_RANK = 384
MLA_KV_RANK = 256
MLA_WIDTH = MLA_HEADS * MLA_V_DIM
D_FF = 4 * D_MODEL
BLOCK_Q = 128
ROPE_THETA = 10000.0
NORM_EPS = 1e-6
N_MOD = 6
IN_WIDTHS = (SB_WIDTH, SB_WIDTH, SB_WIDTH, MLA_Q_RANK, MLA_KV_RANK, MLA_ROPE_DIM, D_MODEL, D_MODEL)
IN_DIM = sum(IN_WIDTHS)

kernel_name = "hybrid_stickbreaking_mla_sqrelu_adaln"


def _rms_norm(x, g):
    xf = x.astype(jnp.float32)
    y = xf * lax.rsqrt(jnp.mean(xf * xf, axis=-1, keepdims=True) + NORM_EPS)
    return y.astype(x.dtype) * g


def _split_cols(p, widths):
    outs, start = [], 0
    for w in widths:
        outs.append(p[..., start:start + w])
        start += w
    return outs


def _rope_tables(positions):
    inv_freq = 1.0 / (ROPE_THETA ** (jnp.arange(0, MLA_ROPE_DIM, 2, dtype=jnp.float32) / MLA_ROPE_DIM))
    ang = positions.astype(jnp.float32)[..., None] * inv_freq
    return jnp.cos(ang), jnp.sin(ang)


def _apply_rope(t, cos, sin):
    half = t.shape[-1] // 2
    t1, t2 = t[..., :half], t[..., half:]
    cs = cos[:, :, None, :].astype(t.dtype)
    sn = sin[:, :, None, :].astype(t.dtype)
    return jnp.concatenate([t1 * cs - t2 * sn, t2 * cs + t1 * sn], axis=-1)


def _stick_breaking_weights(z, mask):
    log_fail = jnp.where(mask, jax.nn.log_sigmoid(-z), 0.0)
    later = lax.cumsum(log_fail, axis=3, reverse=True) - log_fail
    return jnp.where(mask, jnp.exp(jax.nn.log_sigmoid(z) + later), 0.0)


def _softmax_weights(z, mask):
    return jax.nn.softmax(jnp.where(mask, z, -jnp.inf), axis=-1)


def _causal_block_attention(q, k, v, weight_fn, strict):
    seq = q.shape[1]
    scale = q.shape[-1] ** -0.5
    outs = []
    for t0 in range(0, seq, BLOCK_Q):
        end = t0 + BLOCK_Q
        z = jnp.einsum('bqhd,bkhd->bhqk', q[:, t0:end].astype(jnp.float32),
                       k[:, :end].astype(jnp.float32)) * scale
        t_idx = t0 + jnp.arange(BLOCK_Q)[:, None]
        s_idx = jnp.arange(end)[None, :]
        mask = (s_idx < t_idx) if strict else (s_idx <= t_idx)
        w = weight_fn(z, mask)
        outs.append(jnp.einsum('bhqk,bkhd->bqhd', w.astype(v.dtype), v[:, :end]))
    return jnp.concatenate(outs, axis=1)


def setup_inputs(seed: int = 0) -> dict:
    key = jax.random.key(seed)
    ks = jax.random.split(key, 20)

    def nrm(k, shape, fan_in):
        return jax.random.normal(k, shape, jnp.float32) * (fan_in ** -0.5)

    def gain(k, shape):
        return 1.0 + 0.05 * jax.random.normal(k, shape, jnp.float32)

    x = jax.random.normal(ks[0], (BATCH, SEQ, D_MODEL), jnp.float32)
    c = jax.random.normal(ks[1], (BATCH, D_MODEL), jnp.float32)
    offsets = jax.random.randint(ks[2], (BATCH, 1), 0, 1024, dtype=jnp.int32)
    positions = (offsets + jnp.arange(SEQ, dtype=jnp.int32)[None, :]).astype(jnp.int32)
    return {
        "x": x,
        "c": c,
        "positions": positions,
        "w_ada": nrm(ks[3], (DEPTH, D_MODEL, N_MOD * D_MODEL), D_MODEL),
        "b_ada": 0.02 * jax.random.normal(ks[4], (DEPTH, N_MOD * D_MODEL), jnp.float32),
        "g_mix_norm": gain(ks[5], (DEPTH, D_MODEL)),
        "w_in": nrm(ks[6], (DEPTH, D_MODEL, IN_DIM), D_MODEL),
        "g_q_lat": gain(ks[7], (DEPTH, MLA_Q_RANK)),
        "w_q_up": nrm(ks[8], (DEPTH, MLA_Q_RANK, MLA_HEADS * MLA_QK_DIM), MLA_Q_RANK),
        "g_kv_lat": gain(ks[9], (DEPTH, MLA_KV_RANK)),
        "w_kv_up": nrm(ks[10], (DEPTH, MLA_KV_RANK, MLA_HEADS * (MLA_NOPE_DIM + MLA_V_DIM)), MLA_KV_RANK),
        "w_sb_out": nrm(ks[11], (DEPTH, SB_WIDTH, D_MODEL), SB_WIDTH),
        "w_mla_out": nrm(ks[12], (DEPTH, MLA_WIDTH, D_MODEL), MLA_WIDTH),
        "w_mix_out": nrm(ks[13], (DEPTH, D_MODEL, D_MODEL), D_MODEL),
        "g_mlp_norm": gain(ks[14], (DEPTH, D_MODEL)),
        "w_up": nrm(ks[15], (DEPTH, D_MODEL, D_FF), D_MODEL),
        "w_down": nrm(ks[16], (DEPTH, D_FF, D_MODEL), D_FF),
        "g_final": gain(ks[17], (D_MODEL,)),
    }


def reference(x, c, positions, w_ada, b_ada, g_mix_norm, w_in, g_q_lat, w_q_up,
              g_kv_lat, w_kv_up, w_sb_out, w_mla_out, w_mix_out, g_mlp_norm,
              w_up, w_down, g_final):
    B, S, _ = x.shape
    cos, sin = _rope_tables(positions)
    c_act = jax.nn.silu(c)
    for l in range(DEPTH):
        mod = (c_act @ w_ada[l] + b_ada[l])[:, None, :]
        shift1, scale1, gate1, shift2, scale2, gate2 = jnp.split(mod, N_MOD, axis=-1)

        h = _rms_norm(x, g_mix_norm[l]) * (1.0 + scale1) + shift1
        p = h @ w_in[l]
        q_sb, k_sb, v_sb, q_lat, kv_lat, k_rope, gate_sb, gate_mla = _split_cols(p, IN_WIDTHS)

        o_sb = _causal_block_attention(
            q_sb.reshape(B, S, SB_HEADS, SB_HEAD_DIM),
            k_sb.reshape(B, S, SB_HEADS, SB_HEAD_DIM),
            v_sb.reshape(B, S, SB_HEADS, SB_HEAD_DIM),
            _stick_breaking_weights, strict=True)
        o_sb = o_sb.reshape(B, S, SB_WIDTH) @ w_sb_out[l]

        q = (_rms_norm(q_lat, g_q_lat[l]) @ w_q_up[l]).reshape(B, S, MLA_HEADS, MLA_QK_DIM)
        kv = (_rms_norm(kv_lat, g_kv_lat[l]) @ w_kv_up[l]).reshape(
            B, S, MLA_HEADS, MLA_NOPE_DIM + MLA_V_DIM)
        k_nope, v_mla = kv[..., :MLA_NOPE_DIM], kv[..., MLA_NOPE_DIM:]
        q_full = jnp.concatenate(
            [q[..., :MLA_NOPE_DIM], _apply_rope(q[..., MLA_NOPE_DIM:], cos, sin)], axis=-1)
        k_pe = _apply_rope(k_rope[:, :, None, :], cos, sin)
        k_full = jnp.concatenate(
            [k_nope, jnp.broadcast_to(k_pe, (B, S, MLA_HEADS, MLA_ROPE_DIM))], axis=-1)
        o_mla = _causal_block_attention(q_full, k_full, v_mla, _softmax_weights, strict=False)
        o_mla = o_mla.reshape(B, S, MLA_WIDTH) @ w_mla_out[l]

        merged = jax.nn.sigmoid(gate_sb) * o_sb + jax.nn.sigmoid(gate_mla) * o_mla
        x = x + gate1 * (merged @ w_mix_out[l])

        h = _rms_norm(x, g_mlp_norm[l]) * (1.0 + scale2) + shift2
        x = x + gate2 * (jnp.square(jax.nn.relu(h @ w_up[l])) @ w_down[l])

    return _rms_norm(x, g_final)
```

```cpp
#include <hip/hip_runtime.h>
#include <cstdio>
#include <cstdint>

#ifndef MK_N_LAUNCHES
#define MK_N_LAUNCHES 1
#endif

#define LAS __attribute__((address_space(3)))
#define GAS __attribute__((address_space(1)))
typedef unsigned short bf16_t;
typedef short bf16x8 __attribute__((ext_vector_type(8)));
typedef short s16x4 __attribute__((ext_vector_type(4)));
typedef float f32x2 __attribute__((ext_vector_type(2)));
typedef float f32x4 __attribute__((ext_vector_type(4)));
typedef float f32x16 __attribute__((ext_vector_type(16)));
typedef unsigned u32x2 __attribute__((ext_vector_type(2)));
typedef unsigned u32x4 __attribute__((ext_vector_type(4)));
typedef __bf16 bf16x2_t __attribute__((ext_vector_type(2)));

constexpr int DM = 1024, NB = 8, SEQ = 2048, MTOK = NB * SEQ, DEPTH = 4, FF = 4096;
constexpr int NPJ = 4352;
constexpr int C_QSB = 0, C_KSB = 512, C_VSB = 1024, C_QLAT = 1536, C_KVLAT = 1920, C_KROPE = 2176, C_GSB = 2304, C_GMLA = 3328;
constexpr int IN_NAT = 4256, IN_SPLIT = 2208;
constexpr int QRANK = 384, KVRANK = 256, QFULL = 768, KVW = 1024;
constexpr float NORM_EPS = 1e-6f;
constexpr float LOG2E = 1.4426950408889634f;
constexpr float C2SB = 0.125f * LOG2E;
constexpr float C2MLA = 0.10206207261596577f * LOG2E;

constexpr size_t MiB = 1u << 20;
constexpr size_t WS_CTL = 0, CTL_ZERO_BYTES = 1 * MiB;
constexpr size_t WS_COS = 1 * MiB, WS_SIN = 2 * MiB;
constexpr size_t WS_MODS = 3 * MiB;
constexpr size_t WS_W = 4 * MiB;
constexpr size_t OW_IN = 0, OW_QUP = OW_IN + (size_t)NPJ * DM * 2, OW_KVUP = OW_QUP + (size_t)QFULL * QRANK * 2, OW_SB = OW_KVUP + (size_t)KVW * KVRANK * 2,
                 OW_MLA = OW_SB + (size_t)DM * 512 * 2, OW_MIX = OW_MLA + (size_t)DM * 512 * 2, OW_UP = OW_MIX + (size_t)DM * DM * 2, OW_DOWN = OW_UP + (size_t)FF * DM * 2,
                 LAYER_W = OW_DOWN + (size_t)DM * FF * 2;
constexpr size_t WS_P = 123 * MiB;
constexpr size_t WS_QF = 259 * MiB;
constexpr size_t WS_KV = 283 * MiB;
constexpr size_t WS_QN = 315 * MiB;
constexpr size_t WS_KVN = 327 * MiB;
constexpr size_t WS_KPE = 335 * MiB;
constexpr size_t WS_H = 336 * MiB;
constexpr size_t WS_END = 368 * MiB;
static_assert(WS_W + DEPTH * LAYER_W <= WS_P, "weights fit");

constexpr int RING_BYTES = 131072;
constexpr int LDSCTL_OFF = RING_BYTES, MISC_OFF = LDSCTL_OFF + 320;
constexpr int LDS_BYTES = 147456;
constexpr int NWAVES = 8;

#ifndef USE_F16
#define USE_F16 1
#endif
typedef _Float16 half2_t __attribute__((ext_vector_type(2)));
typedef _Float16 half8_t __attribute__((ext_vector_type(8)));
#if USE_F16
__device__ __forceinline__ unsigned cvtpk(float lo, float hi) { f32x2 v = {lo, hi}; half2_t b = __builtin_convertvector(v, half2_t); return __builtin_bit_cast(unsigned, b); }
__device__ __forceinline__ float bf2f(unsigned short h) { return (float)__builtin_bit_cast(_Float16, h); }
__device__ __forceinline__ float up_lo(unsigned w) { return (float)__builtin_bit_cast(half2_t, w)[0]; }
__device__ __forceinline__ float up_hi(unsigned w) { return (float)__builtin_bit_cast(half2_t, w)[1]; }
#define MFMA16(a, b, c) __builtin_amdgcn_mfma_f32_16x16x32_f16(__builtin_bit_cast(half8_t, a), __builtin_bit_cast(half8_t, b), c, 0, 0, 0)
#define MFMA32(a, b, c) __builtin_amdgcn_mfma_f32_32x32x16_f16(__builtin_bit_cast(half8_t, a), __builtin_bit_cast(half8_t, b), c, 0, 0, 0)
#else
__device__ __forceinline__ unsigned cvtpk(float lo, float hi) { f32x2 v = {lo, hi}; bf16x2_t b = __builtin_convertvector(v, bf16x2_t); return __builtin_bit_cast(unsigned, b); }
__device__ __forceinline__ float bf2f(unsigned short h) { return __builtin_bit_cast(float, (unsigned)h << 16); }
__device__ __forceinline__ float up_lo(unsigned w) { return __builtin_bit_cast(float, w << 16); }
__device__ __forceinline__ float up_hi(unsigned w) { return __builtin_bit_cast(float, w & 0xffff0000u); }
#define MFMA16(a, b, c) __builtin_amdgcn_mfma_f32_16x16x32_bf16(a, b, c, 0, 0, 0)
#endif
__device__ __forceinline__ void st4bf(bf16_t* p, f32x4 v) { u32x2 w; w.x = cvtpk(v[0], v[1]); w.y = cvtpk(v[2], v[3]); *(GAS u32x2*)p = w; }
__device__ __forceinline__ f32x4 bf4(u32x2 w) { f32x4 r; r[0] = up_lo(w.x); r[1] = up_hi(w.x); r[2] = up_lo(w.y); r[3] = up_hi(w.y); return r; }
__device__ __forceinline__ f32x4 ld4bf(const bf16_t* p) { return bf4(*(const GAS u32x2*)p); }
#define swz_xor(v, pat) __builtin_bit_cast(float, __builtin_amdgcn_ds_swizzle(__builtin_bit_cast(int, (float)(v)), (pat)))
__device__ __forceinline__ void swap32(float& a, float& b) { asm volatile("s_nop 1\n\tv_permlane32_swap_b32 %0, %1" : "+v"(a), "+v"(b)); }
__device__ __forceinline__ float sum_halves(float v) { float a = v, b = v; swap32(a, b); return a + b; }
__device__ __forceinline__ float max_halves(float v) { float a = v, b = v; swap32(a, b); return fmaxf(a, b); }
__device__ __forceinline__ float other_half(float v, int hi) { float a = v, b = v; swap32(a, b); return hi ? a : b; }
#ifndef DBG_SHFL_SUM
#define DBG_SHFL_SUM 0
#endif
__device__ __forceinline__ float wave_sum(float v) {
#if DBG_SHFL_SUM
#pragma unroll
    for (int o = 1; o < 64; o <<= 1) v += __shfl_xor(v, o);
    return v;
#else
    v += swz_xor(v, (1 << 10) | 0x1f); v += swz_xor(v, (2 << 10) | 0x1f); v += swz_xor(v, (4 << 10) | 0x1f); v += swz_xor(v, (8 << 10) | 0x1f); v += swz_xor(v, (16 << 10) | 0x1f);
    return sum_halves(v);
#endif
}
#define LDS_WAIT() asm volatile("s_waitcnt lgkmcnt(0)" ::: "memory")
#define VM_WAIT() asm volatile("s_waitcnt vmcnt(0)" ::: "memory")

namespace pg8 {
constexpr int BM = 256, BK = 64, HALF = 128, HTB = HALF * BK * 2, STAGE_BYTES = 8 * HTB, NXCD = 8, WGM = 8;
__host__ __device__ __forceinline__ int lds_byte(int r, int c) { const int st = (r >> 4) * 2 + (c >> 5), rr = r & 15, cc = c & 31, ob = rr * 64 + cc * 2; return st * 1024 + (ob ^ (((ob >> 9) & 1) << 5)); }
__host__ __device__ __forceinline__ void stage_rc(int b, int& R, int& C) { const int st = b / 1024, sb = b % 1024, swz = sb ^ (((sb >> 9) & 1) << 5); R = (st >> 1) * 16 + swz / 64; C = (st & 1) * 32 + (swz % 64) / 2; }

struct Unit { int pm, pn, z; };
struct Gemm { const bf16_t* A; const bf16_t* Bt; const bf16_t* A2; const bf16_t* Bt2; int lda, ldb, K; };

struct StaticOrder {
    int nM, nN, nwg, G, c;
    __host__ __device__ void init(int M, int N, int G_, int c_) { nM = M / BM; nN = N / BM; nwg = nM * nN; G = G_; c = c_; }
    __host__ __device__ bool next(int i, Unit& u) const {
        const long L = (long)i * G + c; if (L >= nwg) return false;
        int wgid = (int)L; { const int q = nwg / NXCD, r = nwg % NXCD, xcd = wgid % NXCD, off = wgid / NXCD; wgid = (xcd < r ? xcd * (q + 1) : r * (q + 1) + (xcd - r) * q) + off; }
        const int nig = WGM * nN, gid = wgid / nig, fm = gid * WGM, gsz = (nM - fm) < WGM ? (nM - fm) : WGM;
        u.pm = fm + ((wgid % nig) % gsz); u.pn = (wgid % nig) / gsz; u.z = 0; return true;
    }
};
struct Order {
    StaticOrder s; int pair;
    __host__ __device__ bool next(int i, Unit& u) const { if (!s.next(pair ? (i >> 1) : i, u)) return false; u.z = pair ? (i & 1) : 0; return true; }
};

template <class F> struct Epi {
    F f;
    __device__ __forceinline__ void operator()(const f32x4 (&acc)[2][2][4][2], const Unit& u, int wr, int wc, int fr, int fq) const {
        { unsigned z_ = 0u; asm volatile("" : "+v"(z_)); const int l_ = (int)__builtin_amdgcn_mbcnt_hi(~0u, __builtin_amdgcn_mbcnt_lo(~0u, z_)); fr = l_ & 15; fq = l_ >> 4; }
#pragma unroll
        for (int bj = 0; bj < 2; ++bj) {
            const int col = u.pn * BM + bj * HALF + wc * 32 + 4 * fq;
            const int row0 = u.pm * BM + wr * 64 + fr;
            const typename F::Ctx cx = f.prep(u, col);
            typename F::Ld ld = f.load(cx, u, row0, col);
#pragma unroll
            for (int it = 0; it < 8; ++it) {
                const int ai = it >> 2, m = it & 3, row = row0 + ai * HALF + m * 16;
                typename F::Ld nl = ld;
                if (it < 7) nl = f.load(cx, u, row0 + ((it + 1) >> 2) * HALF + ((it + 1) & 3) * 16, col);
                f.finish(cx, u, row, col, ld, acc[ai][bj][m][0], acc[ai][bj][m][1]);
                asm volatile("" ::: "memory");
                ld = nl;
            }
        }
    }
};

template <class EpiT, class Sched, bool ALIGN_EPI>
__device__ __forceinline__ void gemm_phase(LAS unsigned char* lds, int tid, const Gemm g, const Sched& S, const EpiT& E) {
    asm volatile("" : "+v"(tid));
    const int wid = __builtin_amdgcn_readfirstlane(tid >> 6), lane = tid & 63, wr = wid >> 2, wc = wid & 3, fr = lane & 15, fq = lane >> 4;
    const int K = g.K, nt = K / BK;
    unsigned voffA[2], voffB[2];
#pragma unroll
    for (int i = 0; i < 2; ++i) { int R, C; stage_rc(tid * 16 + i * 8192, R, C);
        voffA[i] = (unsigned)(R * g.lda + C) * 2u; voffB[i] = (unsigned)(R * g.ldb + C) * 2u; }
    const size_t kstep = (size_t)(BK * 2);
    const size_t hstepA = (size_t)HALF * g.lda * 2, hstepB = (size_t)HALF * g.ldb * 2;
    const size_t tstepA = 2 * hstepA, tstepB = 2 * hstepB;
    const unsigned ldsw = (unsigned)wid * 1024u;
    const int aoff = lds_byte(wr * 64 + fr, fq * 8), boff = lds_byte(wc * 32 + fr, fq * 8);
#define PG8_SA(b, h) (((b) * 2 + (h)) * HTB)
#define PG8_SB(b, h) ((4 + (b) * 2 + (h)) * HTB)
#define PG8_STAGE(bufoff, gbase, voff) do { _Pragma("unroll") for (int _i = 0; _i < 2; ++_i) \
        __builtin_amdgcn_global_load_lds((const unsigned*)((const char*)(gbase) + (voff)[_i]), (LAS unsigned*)(lds + (bufoff) + ldsw + _i * 8192), 16, 0, 0); } while (0)
#define PG8_LDA(dst, b, h) do { _Pragma("unroll") for (int m = 0; m < 4; ++m) _Pragma("unroll") for (int k = 0; k < 2; ++k) dst[m][k] = *(const LAS bf16x8*)(lds + PG8_SA(b, h) + aoff + m * 2048 + k * 1024); } while (0)
#define PG8_LDB(dst, b, h) do { _Pragma("unroll") for (int n = 0; n < 2; ++n) _Pragma("unroll") for (int k = 0; k < 2; ++k) dst[n][k] = *(const LAS bf16x8*)(lds + PG8_SB(b, h) + boff + n * 2048 + k * 1024); } while (0)
#define PG8_MMA(ai, bj, At, Bt) do { __builtin_amdgcn_s_setprio(1); _Pragma("unroll") for (int m = 0; m < 4; ++m) _Pragma("unroll") for (int n = 0; n < 2; ++n) _Pragma("unroll") for (int k = 0; k < 2; ++k) \
        acc[ai][bj][m][n] = MFMA16(Bt[n][k], At[m][k], acc[ai][bj][m][n]); __builtin_amdgcn_s_setprio(0); } while (0)
#define PG8_WAIT_V(n) asm volatile("s_waitcnt vmcnt(" #n ")" ::: "memory")
#define PG8_WAIT_L(n) asm volatile("s_waitcnt lgkmcnt(" #n ")" ::: "memory")
#define PG8_BAR __builtin_amdgcn_s_barrier()
#define PG8_SCHED __builtin_amdgcn_sched_barrier(0)
    Unit cur, nxt; int ui = 0;
    if (!S.next(0, cur)) return;
    f32x4 acc[2][2][4][2];
    { float zf = 0.f; asm volatile("" : "+v"(zf));
#pragma unroll
    for (int a = 0; a < 2; ++a)
#pragma unroll
        for (int b = 0; b < 2; ++b)
#pragma unroll
            for (int m = 0; m < 4; ++m)
#pragma unroll
                for (int n = 0; n < 2; ++n) acc[a][b][m][n] = (f32x4){zf, zf, zf, zf}; }
    bf16x8 At[4][2], B0[2][2], B1[2][2];
    const char* cA = (const char*)(cur.z ? g.A2 : g.A) + (size_t)cur.pm * tstepA; const char* cB = (const char*)(cur.z ? g.Bt2 : g.Bt) + (size_t)cur.pn * tstepB;
    PG8_STAGE(PG8_SB(0, 0), cB, voffB); PG8_STAGE(PG8_SB(0, 1), cB + hstepB, voffB); PG8_STAGE(PG8_SA(0, 0), cA, voffA); PG8_STAGE(PG8_SA(0, 1), cA + hstepA, voffA);
    if (wr == 1) PG8_BAR;
    PG8_WAIT_V(2); PG8_BAR;
    PG8_STAGE(PG8_SB(1, 0), cB + kstep, voffB); PG8_STAGE(PG8_SA(1, 0), cA + kstep, voffA); PG8_STAGE(PG8_SB(1, 1), cB + hstepB + kstep, voffB);
    PG8_WAIT_V(6); PG8_BAR;
    for (;;) {
        const bool has_next = S.next(ui + 1, nxt);
        const char* nA = has_next ? (const char*)(nxt.z ? g.A2 : g.A) + (size_t)nxt.pm * tstepA : cA; const char* nB = has_next ? (const char*)(nxt.z ? g.Bt2 : g.Bt) + (size_t)nxt.pn * tstepB : cB;
        for (int t = 0; t < nt; t += 2) {
            const bool last = (t == nt - 2);
            const char* a1 = cA + (size_t)(t + 1) * kstep;
            const char* a2 = last ? nA : cA + (size_t)(t + 2) * kstep; const char* b2 = last ? nB : cB + (size_t)(t + 2) * kstep;
            const char* a3 = a2 + kstep; const char* b3 = b2 + kstep;
            PG8_LDB(B0, 0, 0); PG8_LDB(B1, 0, 1); PG8_SCHED; PG8_LDA(At, 0, 0); PG8_STAGE(PG8_SA(1, 1), a1 + hstepA, voffA);
            PG8_WAIT_V(8); PG8_WAIT_L(0); PG8_BAR; PG8_MMA(0, 0, At, B0); PG8_MMA(0, 1, At, B1); PG8_BAR; PG8_SCHED;
            PG8_LDA(At, 0, 1); PG8_STAGE(PG8_SB(0, 0), b2, voffB); PG8_STAGE(PG8_SB(0, 1), b2 + hstepB, voffB); PG8_STAGE(PG8_SA(0, 0), a2, voffA);
            PG8_WAIT_V(8); PG8_WAIT_L(0); PG8_BAR; PG8_MMA(1, 0, At, B0); PG8_MMA(1, 1, At, B1); PG8_BAR; PG8_SCHED;
            PG8_LDB(B0, 1, 0); PG8_LDB(B1, 1, 1); PG8_SCHED; PG8_LDA(At, 1, 0); PG8_STAGE(PG8_SA(0, 1), a2 + hstepA, voffA);
            PG8_WAIT_V(8); PG8_WAIT_L(0); PG8_BAR; PG8_MMA(0, 0, At, B0); PG8_MMA(0, 1, At, B1); PG8_BAR; PG8_SCHED;
            PG8_LDA(At, 1, 1); PG8_STAGE(PG8_SB(1, 0), b3, voffB); PG8_STAGE(PG8_SB(1, 1), b3 + hstepB, voffB); PG8_STAGE(PG8_SA(1, 0), a3, voffA);
            PG8_WAIT_V(8); PG8_WAIT_L(0); PG8_BAR; PG8_MMA(1, 0, At, B0); PG8_MMA(1, 1, At, B1); PG8_BAR; PG8_SCHED;
        }
        if constexpr (ALIGN_EPI) { if (wr == 0) PG8_BAR; }
        E(acc, cur, wr, wc, fr, fq);
        if (!has_next) break;
        { float zf = 0.f; asm volatile("" : "+v"(zf));
#pragma unroll
        for (int a = 0; a < 2; ++a)
#pragma unroll
            for (int b = 0; b < 2; ++b)
#pragma unroll
                for (int m = 0; m < 4; ++m)
#pragma unroll
                    for (int n = 0; n < 2; ++n) acc[a][b][m][n] = (f32x4){zf, zf, zf, zf}; }
        cur = nxt; cA = nA; cB = nB; ++ui;
        if constexpr (ALIGN_EPI) { if (wr == 1) PG8_BAR; }
    }
    PG8_WAIT_V(0);
    if constexpr (!ALIGN_EPI) { if (wr == 0) PG8_BAR; }
    PG8_BAR;
#undef PG8_SA
#undef PG8_SB
#undef PG8_STAGE
#undef PG8_LDA
#undef PG8_LDB
#undef PG8_MMA
#undef PG8_WAIT_V
#undef PG8_WAIT_L
#undef PG8_BAR
#undef PG8_SCHED
}
}

struct LdNone { int d; };
struct F_ProjA {
    bf16_t* P;
    struct Ctx { float sc; }; typedef LdNone Ld;
    __device__ __forceinline__ Ctx prep(const pg8::Unit& u, int) const { Ctx c; c.sc = (u.pn < 2) ? C2SB : 1.0f; return c; }
    __device__ __forceinline__ Ld load(const Ctx&, const pg8::Unit&, int, int) const { Ld l; l.d = 0; return l; }
    __device__ __forceinline__ void finish(const Ctx& c, const pg8::Unit&, int row, int col, const Ld&, f32x4 v0, f32x4 v1) const {
        bf16_t* o = P + (size_t)row * NPJ + col; st4bf(o, v0 * c.sc); st4bf(o + 16, v1 * c.sc); }
};
struct F_Qup {
    bf16_t* Q; const float* cosT; const float* sinT;
    struct Ctx { int rope; }; struct Ld { f32x4 ct, st; };
    __device__ __forceinline__ Ctx prep(const pg8::Unit&, int col) const { Ctx c; c.rope = (((col >> 5) % 3) == 2) ? 1 : 0; return c; }
    __device__ __forceinline__ Ld load(const Ctx& c, const pg8::Unit&, int row, int col) const { Ld l; const int i0 = col & 15;
        l.ct = *(const GAS f32x4*)(cosT + (size_t)row * 16 + i0); l.st = *(const GAS f32x4*)(sinT + (size_t)row * 16 + i0); return l; }
    __device__ __forceinline__ void finish(const Ctx& c, const pg8::Unit&, int row, int col, const Ld& l, f32x4 v0, f32x4 v1) const {
        if (c.rope) { const f32x4 a = v0 * l.ct - v1 * l.st, b = v1 * l.ct + v0 * l.st; v0 = a; v1 = b; }
        bf16_t* o = Q + (size_t)row * QFULL + col; st4bf(o, v0 * C2MLA); st4bf(o + 16, v1 * C2MLA); }
};
struct F_Kvup {
    bf16_t* KV;
    struct Ctx { int d; }; typedef LdNone Ld;
    __device__ __forceinline__ Ctx prep(const pg8::Unit&, int) const { Ctx c; c.d = 0; return c; }
    __device__ __forceinline__ Ld load(const Ctx&, const pg8::Unit&, int, int) const { Ld l; l.d = 0; return l; }
    __device__ __forceinline__ void finish(const Ctx&, const pg8::Unit&, int row, int col, const Ld&, f32x4 v0, f32x4 v1) const {
        bf16_t* o = KV + (size_t)row * KVW + col; st4bf(o, v0); st4bf(o + 16, v1); }
};
__device__ __forceinline__ f32x4 sigmoid4(f32x4 g) { f32x4 r;
#pragma unroll
    for (int i = 0; i < 4; ++i) r[i] = __builtin_amdgcn_rcpf(1.0f + __builtin_amdgcn_exp2f(-LOG2E * g[i]));
    return r; }
struct F_Gate {
    const bf16_t* P; bf16_t* Mg;
    struct Ctx { int goff; }; struct Ld { u32x2 g0, g1, m0, m1; };
    __device__ __forceinline__ Ctx prep(const pg8::Unit& u, int) const { Ctx c; c.goff = u.z ? C_GMLA : C_GSB; return c; }
    __device__ __forceinline__ Ld load(const Ctx& c, const pg8::Unit& u, int row, int col) const { Ld l; const bf16_t* gp = P + (size_t)row * NPJ + c.goff + col;
        l.g0 = *(const GAS u32x2*)gp; l.g1 = *(const GAS u32x2*)(gp + 16); l.m0 = (u32x2){0u, 0u}; l.m1 = (u32x2){0u, 0u};
        if (u.z) { const bf16_t* o = Mg + (size_t)row * DM + col; l.m0 = *(const GAS u32x2*)o; l.m1 = *(const GAS u32x2*)(o + 16); } return l; }
    __device__ __forceinline__ void finish(const Ctx&, const pg8::Unit& u, int row, int col, const Ld& l, f32x4 v0, f32x4 v1) const {
        bf16_t* o = Mg + (size_t)row * DM + col;
        f32x4 r0 = sigmoid4(bf4(l.g0)) * v0, r1 = sigmoid4(bf4(l.g1)) * v1;
        if (u.z) { r0 += bf4(l.m0); r1 += bf4(l.m1); }
        st4bf(o, r0); st4bf(o + 16, r1); }
};
struct F_Resid {
    const float* base; float* X; const float* gate;
    struct Ctx { f32x4 g0, g1; }; struct Ld { f32x4 b0, b1; };
    __device__ __forceinline__ Ctx prep(const pg8::Unit& u, int col) const { Ctx c; const float* gp = gate + (size_t)(u.pm >> 3) * (6 * DM) + col; c.g0 = *(const GAS f32x4*)gp; c.g1 = *(const GAS f32x4*)(gp + 16); return c; }
    __device__ __forceinline__ Ld load(const Ctx&, const pg8::Unit&, int row, int col) const { Ld l; const size_t off = (size_t)row * DM + col; l.b0 = *(const GAS f32x4*)(base + off); l.b1 = *(const GAS f32x4*)(base + off + 16); return l; }
    __device__ __forceinline__ void finish(const Ctx& c, const pg8::Unit&, int row, int col, const Ld& l, f32x4 v0, f32x4 v1) const {
        const size_t off = (size_t)row * DM + col;
        *(GAS f32x4*)(X + off) = l.b0 + c.g0 * v0; *(GAS f32x4*)(X + off + 16) = l.b1 + c.g1 * v1; }
};
struct F_Sqrelu {
    bf16_t* U;
    struct Ctx { int d; }; typedef LdNone Ld;
    __device__ __forceinline__ Ctx prep(const pg8::Unit&, int) const { Ctx c; c.d = 0; return c; }
    __device__ __forceinline__ Ld load(const Ctx&, const pg8::Unit&, int, int) const { Ld l; l.d = 0; return l; }
    __device__ __forceinline__ void finish(const Ctx&, const pg8::Unit&, int row, int col, const Ld&, f32x4 v0, f32x4 v1) const {
        const f32x4 z = {0.f, 0.f, 0.f, 0.f};
        f32x4 a = __builtin_elementwise_max(v0, z), b = __builtin_elementwise_max(v1, z);
        bf16_t* o = U + (size_t)row * FF + col; st4bf(o, a * a); st4bf(o + 16, b * b); }
};

#ifndef DBG_NAIVE_GEMM
#define DBG_NAIVE_GEMM 0
#endif
template <class F>
__device__ __forceinline__ void naive_gemm_f(const F& f, int gtid, int nthreads, const pg8::Gemm g, int N, int npass) {
    const int ngrp = N / 32 * 4;
    for (int z = 0; z < npass; ++z) {
        const bf16_t* A = z ? g.A2 : g.A; const bf16_t* Bt = z ? g.Bt2 : g.Bt;
        for (long idx = gtid; idx < (long)MTOK * ngrp; idx += nthreads) {
            const int row = (int)(idx % MTOK), gj = (int)(idx / MTOK), col = (gj >> 2) * 32 + (gj & 3) * 4;
            float a0[4] = {0.f, 0.f, 0.f, 0.f}, a1[4] = {0.f, 0.f, 0.f, 0.f};
            const GAS bf16_t* ar = (const GAS bf16_t*)A + (size_t)row * g.lda;
            for (int k = 0; k < g.K; ++k) { const float av = bf2f(ar[k]);
#pragma unroll
                for (int e = 0; e < 4; ++e) { a0[e] += av * bf2f(((const GAS bf16_t*)Bt)[(size_t)(col + e) * g.ldb + k]); a1[e] += av * bf2f(((const GAS bf16_t*)Bt)[(size_t)(col + 16 + e) * g.ldb + k]); } }
            pg8::Unit u; u.pm = row >> 8; u.pn = col >> 8; u.z = z;
            const typename F::Ctx cx = f.prep(u, col); const typename F::Ld ld = f.load(cx, u, row, col);
            f.finish(cx, u, row, col, ld, (f32x4){a0[0], a0[1], a0[2], a0[3]}, (f32x4){a1[0], a1[1], a1[2], a1[3]});
        }
        VM_WAIT(); __syncthreads();
    }
}

struct EpiAll {
    int kind; void* o; const void* p1; const void* p2;
    template <class F> __device__ __forceinline__ void run(const F& f, const f32x4 (&acc)[2][2][4][2], const pg8::Unit& u, int wr, int wc) const { pg8::Epi<F> e{f}; e(acc, u, wr, wc, 0, 0); }
    __device__ __forceinline__ void operator()(const f32x4 (&acc)[2][2][4][2], const pg8::Unit& u, int wr, int wc, int, int) const {
        if (kind == 0) run(F_ProjA{(bf16_t*)o}, acc, u, wr, wc);
        else if (kind == 1) run(F_Qup{(bf16_t*)o, (const float*)p1, (const float*)p2}, acc, u, wr, wc);
        else if (kind == 2) run(F_Kvup{(bf16_t*)o}, acc, u, wr, wc);
        else if (kind == 3) run(F_Gate{(const bf16_t*)p1, (bf16_t*)o}, acc, u, wr, wc);
        else if (kind == 4) run(F_Resid{(const float*)p1, (float*)o, (const float*)p2}, acc, u, wr, wc);
        else run(F_Sqrelu{(bf16_t*)o}, acc, u, wr, wc);
    }
    __device__ __forceinline__ void naive(int gtid, int nthreads, const pg8::Gemm& g, int N, int npass) const {
        if (kind == 0) naive_gemm_f(F_ProjA{(bf16_t*)o}, gtid, nthreads, g, N, npass);
        else if (kind == 1) naive_gemm_f(F_Qup{(bf16_t*)o, (const float*)p1, (const float*)p2}, gtid, nthreads, g, N, npass);
        else if (kind == 2) naive_gemm_f(F_Kvup{(bf16_t*)o}, gtid, nthreads, g, N, npass);
        else if (kind == 3) naive_gemm_f(F_Gate{(const bf16_t*)p1, (bf16_t*)o}, gtid, nthreads, g, N, npass);
        else if (kind == 4) naive_gemm_f(F_Resid{(const float*)p1, (float*)o, (const float*)p2}, gtid, nthreads, g, N, npass);
        else naive_gemm_f(F_Sqrelu{(bf16_t*)o}, gtid, nthreads, g, N, npass);
    }
};


__device__ __forceinline__ int crow(int r, int hi) { return (r & 3) + 8 * (r >> 2) + 4 * hi; }
typedef short v4i16_t __attribute__((ext_vector_type(4)));
__device__ __forceinline__ s16x4 vtr(const LAS unsigned char* p) { return __builtin_bit_cast(s16x4, __builtin_amdgcn_ds_read_tr16_b64_v4i16((LAS v4i16_t*)p)); }

template <bool DIAG>
__device__ __forceinline__ void sb_half(const f32x16& y16, float& R, int kb, int tq, int hi, u32x4& pwa, u32x4& pwb) {
    float lf[16], ls[16];
#pragma unroll
    for (int r = 0; r < 16; ++r) {
        const float y = y16[r];
        const float sp = fmaxf(y, 0.f) + __builtin_amdgcn_logf(1.0f + __builtin_amdgcn_exp2f(-fabsf(y)));
        float l = -sp, s = y - sp;
        if (DIAG) { const bool valid = (kb + crow(r, hi)) < tq; l = valid ? l : 0.f; s = valid ? s : -INFINITY; }
        lf[r] = l; ls[r] = s;
    }
    float G[4], OS[4];
#pragma unroll
    for (int g = 0; g < 4; ++g) G[g] = (lf[4 * g] + lf[4 * g + 1]) + (lf[4 * g + 2] + lf[4 * g + 3]);
    OS[3] = G[3];
#pragma unroll
    for (int g = 2; g >= 0; --g) OS[g] = G[g] + OS[g + 1];
    const float T = sum_halves(OS[0]);
#pragma unroll
    for (int g = 0; g < 4; ++g) {
        const float ex = (g < 3) ? OS[g + 1] : 0.f;
        const float snd = hi ? OS[g] : ex;
        const float rcv = other_half(snd, hi);
        float w = R + ex + rcv;
        const float a3 = __builtin_amdgcn_exp2f(ls[4 * g + 3] + w); w += lf[4 * g + 3];
        const float a2 = __builtin_amdgcn_exp2f(ls[4 * g + 2] + w); w += lf[4 * g + 2];
        const float a1 = __builtin_amdgcn_exp2f(ls[4 * g + 1] + w); w += lf[4 * g + 1];
        const float a0 = __builtin_amdgcn_exp2f(ls[4 * g] + w);
        const unsigned lo = cvtpk(a0, a1), up = cvtpk(a2, a3);
        if (g == 0) { pwa[0] = lo; pwa[1] = up; } else if (g == 1) { pwa[2] = lo; pwa[3] = up; } else if (g == 2) { pwb[0] = lo; pwb[1] = up; } else { pwb[2] = lo; pwb[3] = up; }
    }
    R += T;
}
template <bool DIAG>
__device__ __forceinline__ float sm_weights(f32x16& p0, f32x16& p1, float& m, float& l, int kb, int tq, int hi, u32x4 (&pw)[4]) {
    if (DIAG) {
#pragma unroll
        for (int r = 0; r < 16; ++r) { const int key = kb + crow(r, hi); if (key > tq) p0[r] = -INFINITY; if (key + 32 > tq) p1[r] = -INFINITY; }
    }
    float mx = fmaxf(p0[0], p1[0]);
#pragma unroll
    for (int r = 1; r < 16; ++r) mx = fmaxf(mx, fmaxf(p0[r], p1[r]));
    mx = max_halves(mx);
    const float mn = fmaxf(m, mx), alpha = __builtin_amdgcn_exp2f(m - mn);
    m = mn;
    float sum = 0.f;
#pragma unroll
    for (int j = 0; j < 8; ++j) {
        const float a = __builtin_amdgcn_exp2f(p0[2 * j] - mn), b = __builtin_amdgcn_exp2f(p0[2 * j + 1] - mn), c = __builtin_amdgcn_exp2f(p1[2 * j] - mn), d = __builtin_amdgcn_exp2f(p1[2 * j + 1] - mn);
        sum += (a + b) + (c + d);
        pw[j >> 2][j & 3] = cvtpk(a, b); pw[2 + (j >> 2)][j & 3] = cvtpk(c, d);
    }
    l = l * alpha + sum;
    return alpha;
}

template <bool MLA>
__device__ __forceinline__ void attn_unit(LAS unsigned char* lds, int tid, int b, int qb,
                                          const bf16_t* Qp, int qpitch, int qoff, const bf16_t* Kp, int kpitch, int koff, const bf16_t* KPE,
                                          const bf16_t* Vp, int vpitch, int voff, bf16_t* Op, int opitch, int ooff) {
    asm volatile("" : "+v"(tid));
    constexpr int NKS = MLA ? 6 : 4;
    constexpr int BUFB = 20480, VOFF = 12288;
    const int lane = tid & 63, r32 = lane & 31, hi = lane >> 5;
    const int wid = __builtin_amdgcn_readfirstlane(tid >> 6);
    const size_t rowbase = (size_t)b * SEQ;
    const int q0 = qb * 256, tq = q0 + wid * 32 + r32, nt = 4 * qb + 4, wlast = 4 * qb + (wid >> 1);
    bf16x8 qr[NKS];
    { const bf16_t* qrow = Qp + (rowbase + tq) * qpitch + qoff + hi * 8;
#pragma unroll
      for (int ks = 0; ks < NKS; ++ks) qr[ks] = *(const GAS bf16x8*)(qrow + ks * 16); }
    const bf16_t* ksrc = Kp + (rowbase + lane) * kpitch + koff + wid * 8;
    const bf16_t* k2src = KPE + (rowbase + lane) * 32 + (wid & 3) * 8;
    const bf16_t* vsrc = Vp + (rowbase + 16 * (wid & 3) + (lane >> 2)) * vpitch + voff + (wid >> 2) * 32 + (lane & 3) * 8;
    const int kdst = wid * 1024 + lane * 16, k2dst = (8 + (wid & 3)) * 1024 + lane * 16, vdst = VOFF + wid * 1024 + lane * 16;
    const int kfrag = hi * 1024 + r32 * 16;
    const int vfrag = VOFF + ((lane >> 4) & 1) * 32 + (lane & 3) * 8 + (4 * hi + ((lane & 15) >> 2)) * 64;
    f32x16 o0, o1;
#pragma unroll
    for (int r = 0; r < 16; ++r) { o0[r] = 0.f; o1[r] = 0.f; }
    float R = 0.f, m_run = -INFINITY, l_run = 0.f;
    u32x4 kreg, vreg, k2reg;
#define TILE_OF(i) (MLA ? (i) : (nt - 1 - (i)))
#define LOADT(kt) do { kreg = *(const GAS u32x4*)(ksrc + (size_t)(kt) * 64 * kpitch); vreg = *(const GAS u32x4*)(vsrc + (size_t)(kt) * 64 * vpitch); \
        if (MLA) k2reg = *(const GAS u32x4*)(k2src + (size_t)(kt) * 64 * 32); } while (0)
#define WRITET(buf) do { *(LAS u32x4*)(lds + (buf) * BUFB + kdst) = kreg; *(LAS u32x4*)(lds + (buf) * BUFB + vdst) = vreg; \
        if (MLA && wid < 4) *(LAS u32x4*)(lds + (buf) * BUFB + k2dst) = k2reg; } while (0)
    LOADT(TILE_OF(0)); WRITET(0); __syncthreads();
    for (int i = 0; i < nt; ++i) {
        const int kt = TILE_OF(i);
        const bool more = (i + 1 < nt);
        if (more) LOADT(TILE_OF(i + 1));
        if (kt <= wlast) {
            const LAS unsigned char* Kb = lds + (i & 1) * BUFB + kfrag;
            const int kb = kt * 64;
            u32x4 pw[4];
            if (MLA) {
                f32x16 p0, p1;
#pragma unroll
                for (int r = 0; r < 16; ++r) { p0[r] = 0.f; p1[r] = 0.f; }
#pragma unroll
                for (int ks = 0; ks < NKS; ++ks) {
                    const bf16x8 k0 = *(const LAS bf16x8*)(Kb + ks * 2048), k1 = *(const LAS bf16x8*)(Kb + ks * 2048 + 512);
                    p0 = MFMA32(k0, qr[ks], p0); p1 = MFMA32(k1, qr[ks], p1);
                }
                float alpha;
                if (kt == wlast) alpha = sm_weights<true>(p0, p1, m_run, l_run, kb, tq, hi, pw); else alpha = sm_weights<false>(p0, p1, m_run, l_run, kb, tq, hi, pw);
#pragma unroll
                for (int r = 0; r < 16; ++r) { o0[r] *= alpha; o1[r] *= alpha; }
            } else {
#pragma unroll
                for (int sub = 1; sub >= 0; --sub) {
                    f32x16 p;
#pragma unroll
                    for (int r = 0; r < 16; ++r) p[r] = 0.f;
#pragma unroll
                    for (int ks = 0; ks < NKS; ++ks) { const bf16x8 kf = *(const LAS bf16x8*)(Kb + ks * 2048 + sub * 512); p = MFMA32(kf, qr[ks], p); }
                    if (kt == wlast) sb_half<true>(p, R, kb + 32 * sub, tq, hi, pw[2 * sub], pw[2 * sub + 1]); else sb_half<false>(p, R, kb + 32 * sub, tq, hi, pw[2 * sub], pw[2 * sub + 1]);
                }
            }
            const LAS unsigned char* Vb = lds + (i & 1) * BUFB + vfrag;
#pragma unroll
            for (int ks = 0; ks < 4; ++ks) {
                const bf16x8 pa = __builtin_bit_cast(bf16x8, pw[ks]);
                const s16x4 a0 = vtr(Vb + ks * 1024), a1 = vtr(Vb + ks * 1024 + 512), c0 = vtr(Vb + 4096 + ks * 1024), c1 = vtr(Vb + 4096 + ks * 1024 + 512);
                const bf16x8 v0 = {a0[0], a0[1], a0[2], a0[3], a1[0], a1[1], a1[2], a1[3]}, v1 = {c0[0], c0[1], c0[2], c0[3], c1[0], c1[1], c1[2], c1[3]};
                o0 = MFMA32(v0, pa, o0); o1 = MFMA32(v1, pa, o1);
            }
        }
        if (more) WRITET((i + 1) & 1);
        __syncthreads();
    }
#undef TILE_OF
#undef LOADT
#undef WRITET
    if (MLA) { const float lt = sum_halves(l_run); const float inv = 1.0f / lt;
#pragma unroll
        for (int r = 0; r < 16; ++r) { o0[r] *= inv; o1[r] *= inv; } }
    bf16_t* orow = Op + (rowbase + tq) * opitch + ooff + 4 * hi;
#pragma unroll
    for (int g = 0; g < 4; ++g) {
        st4bf(orow + 8 * g, (f32x4){o0[4 * g], o0[4 * g + 1], o0[4 * g + 2], o0[4 * g + 3]});
        st4bf(orow + 32 + 8 * g, (f32x4){o1[4 * g], o1[4 * g + 1], o1[4 * g + 2], o1[4 * g + 3]});
    }
}


#ifndef DBG_NAIVE_SB
#define DBG_NAIVE_SB 0
#endif
#ifndef DBG_NAIVE_MLA
#define DBG_NAIVE_MLA 0
#endif
template <bool MLA>
__device__ __forceinline__ void naive_attn(int gtid, int nthreads, const bf16_t* Qp, int qpitch, int qstride_h, const bf16_t* Kp, int kpitch, int kstride_h, int koff0, const bf16_t* KPE,
                                           const bf16_t* Vp, int vpitch, int vstride_h, int voff0, bf16_t* Op) {
    constexpr int DK = MLA ? 96 : 64;
    for (int idx = gtid; idx < NB * 8 * SEQ; idx += nthreads) {
        const int t = idx % SEQ, h = (idx / SEQ) % 8, b = idx / (SEQ * 8);
        const size_t rowbase = (size_t)b * SEQ;
        float q[DK];
#pragma unroll
        for (int d = 0; d < DK; ++d) q[d] = bf2f(((const GAS bf16_t*)Qp)[(rowbase + t) * qpitch + h * qstride_h + d]);
        float o[64];
#pragma unroll
        for (int d = 0; d < 64; ++d) o[d] = 0.f;
        float R = 0.f, m = -INFINITY, l = 0.f;
        const int s_top = __builtin_amdgcn_readfirstlane(t & ~63) + 63;
        for (int s = s_top; s >= 0; --s) {
            const bool valid = MLA ? (s <= t) : (s < t);
            const GAS bf16_t* kr = (const GAS bf16_t*)Kp + (rowbase + s) * kpitch + koff0 + h * kstride_h;
            float y = 0.f;
#pragma unroll
            for (int d = 0; d < 64; ++d) y += q[d] * bf2f(kr[d]);
            if (MLA) {
                const GAS bf16_t* kp2 = (const GAS bf16_t*)KPE + (rowbase + s) * 32;
#pragma unroll
                for (int d = 0; d < 32; ++d) y += q[64 + d] * bf2f(kp2[d]);
            }
            float w = 0.f;
            if (MLA) {
                if (valid) { const float mn = fmaxf(m, y), al = exp2f(m - mn); w = exp2f(y - mn); l = l * al + w; m = mn;
#pragma unroll
                    for (int d = 0; d < 64; ++d) o[d] *= al; }
            } else {
                if (valid) { const float sp = fmaxf(y, 0.f) + log2f(1.0f + exp2f(-fabsf(y))); w = exp2f((y - sp) + R); R -= sp; }
            }
            const GAS bf16_t* vr = (const GAS bf16_t*)Vp + (rowbase + s) * vpitch + voff0 + h * vstride_h;
#pragma unroll
            for (int d = 0; d < 64; ++d) o[d] += w * bf2f(vr[d]);
        }
        const float inv = MLA ? 1.0f / l : 1.0f;
#pragma unroll
        for (int d = 0; d < 64; d += 2) { const unsigned pk = cvtpk(o[d] * inv, o[d + 1] * inv); *(GAS unsigned*)(Op + (rowbase + t) * 512 + h * 64 + d) = pk; }
    }
}

typedef GAS unsigned gu32;
#define RLX_AGENT __ATOMIC_RELAXED, __HIP_MEMORY_SCOPE_AGENT
#define XB_TMO      128
#define XB_XCNT(j)  (256  + 64 * (j))
#define XB_XSUB(j)  (1280 + 64 * (j))
#define XB_XGEN(j)  (2304 + 64 * (j))
#define XB_TOP      3328
#define XB_TOPGEN   3392
#define XCD_BAR_WORDS 3456
#define XB_SPIN_CAP (1u << 18)
constexpr int CW_BAR = 4096;
__device__ __forceinline__ unsigned xb_ld(unsigned* p)              { return __hip_atomic_load(p, __ATOMIC_RELAXED, __HIP_MEMORY_SCOPE_AGENT); }
__device__ __forceinline__ unsigned xb_add(unsigned* p, unsigned v) { return __hip_atomic_fetch_add(p, v, __ATOMIC_RELAXED, __HIP_MEMORY_SCOPE_AGENT); }
__device__ __forceinline__ unsigned xb_xcc_id() { return (unsigned)__builtin_amdgcn_s_getreg((3 << 11) | 20) & 0xFu; }
#define XB_SPIN(cond, bar) do { unsigned _sp = 0; while (cond) { __builtin_amdgcn_s_sleep(1); \
    if ((++_sp & 255u) == 0u) { if (xb_ld(&(bar)[XB_TMO])) break; if (_sp > XB_SPIN_CAP) { atomicAdd(&(bar)[XB_TMO], 1u); break; } } } } while (0)
struct XcdBarrier { unsigned* bar; unsigned x; volatile LAS unsigned* st; };
__device__ __forceinline__ XcdBarrier xcd_barrier_post(unsigned* bar, volatile LAS unsigned* st) {
    XcdBarrier b; b.bar = bar; b.x = xb_xcc_id(); b.st = st;
    if (threadIdx.x == 0) (void)xb_add(&bar[XB_XCNT(b.x)], 1u);
    return b;
}
__device__ __forceinline__ void xcd_barrier_complete(unsigned* bar, unsigned x, unsigned& nloc, unsigned& nx) {
    const unsigned G = gridDim.x * gridDim.y * gridDim.z;
    unsigned sum, cnt, mine, sp = 0u;
    for (;;) {
        sum = 0u; cnt = 0u; mine = 0u;
#pragma unroll 1
        for (unsigned j = 0; j < 16; ++j) { const unsigned c = xb_ld(&bar[XB_XCNT(j)]); sum += c; cnt += (c > 0u) ? 1u : 0u; mine = (j == x) ? c : mine; }
        if (sum == G) break;
        __builtin_amdgcn_s_sleep(1);
        if ((++sp & 255u) == 0u) { if (xb_ld(&bar[XB_TMO])) break; if (sp > XB_SPIN_CAP) { atomicAdd(&bar[XB_TMO], 1u); break; } }
    }
    nloc = mine > 0u ? mine : 1u; nx = cnt > 0u ? cnt : 1u;
}
__device__ __forceinline__ void xcd_barrier(const XcdBarrier& b) {
    asm volatile("s_waitcnt vmcnt(0)" ::: "memory");
    __syncthreads();
    if (threadIdx.x == 0) {
        unsigned* bar = b.bar;
        __builtin_amdgcn_s_waitcnt(0);
        unsigned nloc = b.st[0], nx = b.st[1];
        if (nloc == 0u) { xcd_barrier_complete(bar, b.x, nloc, nx); b.st[0] = nloc; b.st[1] = nx; }
        const unsigned old = xb_add(&bar[XB_XSUB(b.x)], 1u);
        const unsigned gen = old / nloc;
        if (old + 1u == (gen + 1u) * nloc) {
            __builtin_amdgcn_fence(__ATOMIC_RELEASE, "agent");
            asm volatile("s_waitcnt vmcnt(0)" ::: "memory");
            const unsigned og = xb_add(&bar[XB_TOP], 1u);
            const unsigned tg = og / nx;
            if (og + 1u == (tg + 1u) * nx) xb_add(&bar[XB_TOPGEN], 1u);
            else XB_SPIN(xb_ld(&bar[XB_TOPGEN]) == tg, bar);
            __builtin_amdgcn_fence(__ATOMIC_ACQUIRE, "agent");
            xb_add(&bar[XB_XGEN(b.x)], 1u);
            asm volatile("s_waitcnt vmcnt(0)" ::: "memory");
        } else {
            XB_SPIN(xb_ld(&bar[XB_XGEN(b.x)]) == gen, bar);
            __builtin_amdgcn_fence(__ATOMIC_ACQUIRE, "agent");
            asm volatile("s_waitcnt vmcnt(0)" ::: "memory");
        }
    }
    __syncthreads();
}

struct Args { const void* in[18]; float* out; unsigned char* ws; int ph_lo, ph_hi; };
struct Frame {
    LAS unsigned char* lds;
    int tid, lane, wave, vcu, G;
};
typedef const void* cvp_t;
__device__ __forceinline__ const void* arg_in(int i) { const __attribute__((address_space(4))) cvp_t* p = (const __attribute__((address_space(4))) cvp_t*)__builtin_amdgcn_kernarg_segment_ptr(); asm volatile("" : "+s"(p)); return p[i]; }

__device__ __forceinline__ void transpose_item(const float* W, int K, int N, bf16_t* WT, int thresh, int add, const float* gain, LAS float* scr, int item, int lane) {
    const int nblk = N / 32, kb = item / nblk, nb = item % nblk, k0 = 64 * kb, n0 = 32 * nb;
#pragma unroll 8
    for (int i = 0; i < 32; ++i) { const int kk = 2 * i + (lane >> 5); scr[kk * 33 + (lane & 31)] = ((const GAS float*)W)[(size_t)(k0 + kk) * N + n0 + (lane & 31)]; }
    LDS_WAIT(); asm volatile("" ::: "memory");
    const int c = lane & 7;
    float gv[8];
#pragma unroll
    for (int e = 0; e < 8; ++e) gv[e] = gain ? ((const GAS float*)gain)[k0 + 8 * c + e] : 1.0f;
    const int radd = (n0 >= thresh) ? add : 0;
#pragma unroll
    for (int j = 0; j < 4; ++j) { const int n = (lane >> 3) + 8 * j; const LAS float* s = scr + (8 * c) * 33 + n;
        u32x4 o; o.x = cvtpk(s[0 * 33] * gv[0], s[1 * 33] * gv[1]); o.y = cvtpk(s[2 * 33] * gv[2], s[3 * 33] * gv[3]); o.z = cvtpk(s[4 * 33] * gv[4], s[5 * 33] * gv[5]); o.w = cvtpk(s[6 * 33] * gv[6], s[7 * 33] * gv[7]);
        *(GAS u32x4*)(WT + (size_t)(radd + n0 + n) * K + k0 + 8 * c) = o; }
    LDS_WAIT(); asm volatile("" ::: "memory");
}

__device__ __forceinline__ void phase_p0(const Frame& F, unsigned char* ws) {
    const int gt = blockIdx.x * 512 + F.tid, NT = F.G * 512;
    { const int* pos = (const int*)arg_in(2); float* cosT = (float*)(ws + WS_COS); float* sinT = (float*)(ws + WS_SIN);
      for (int idx = gt; idx < MTOK * 16; idx += NT) { const int t = idx >> 4, i = idx & 15;
          const float inv = 1.0f / __builtin_amdgcn_exp2f((float)(2 * i) * (13.287712379549449f / 32.0f));
          const float ang = (float)((const GAS int*)pos)[t] * inv;
          double rev = (double)ang * 0.15915494309189535; rev -= __builtin_rint(rev);
          const float fr = (float)rev;
          ((GAS float*)cosT)[idx] = __builtin_amdgcn_cosf(fr); ((GAS float*)sinT)[idx] = __builtin_amdgcn_sinf(fr); } }
#ifndef DBG_NAIVE_P0
#define DBG_NAIVE_P0 0
#endif
#if DBG_NAIVE_P0
    { const GAS float* c = (const GAS float*)arg_in(1); const GAS float* w_ada = (const GAS float*)arg_in(3); const GAS float* b_ada = (const GAS float*)arg_in(4); GAS float* mods = (GAS float*)(ws + WS_MODS);
      for (int idx = gt; idx < DEPTH * NB * 6 * DM; idx += NT) { const int n = idx % (6 * DM), b = (idx / (6 * DM)) % NB, l = idx / (6 * DM * NB);
          float s = b_ada[l * 6 * DM + n];
          for (int k = 0; k < DM; ++k) { const float v = c[b * DM + k]; s += (v / (1.0f + expf(-v))) * w_ada[((size_t)l * DM + k) * (6 * DM) + n]; }
          mods[idx] = s; }
      struct WD { int in, gi, K, N; size_t ow; };
      const WD wd[8] = {{6, -1, DM, IN_NAT, OW_IN}, {8, 7, QRANK, QFULL, OW_QUP}, {10, 9, KVRANK, KVW, OW_KVUP}, {11, -1, 512, DM, OW_SB}, {12, -1, 512, DM, OW_MLA}, {13, -1, DM, DM, OW_MIX}, {15, -1, DM, FF, OW_UP}, {16, -1, FF, DM, OW_DOWN}};
      for (int l = 0; l < DEPTH; ++l) for (int w = 0; w < 8; ++w) {
          const int K = wd[w].K, N = wd[w].N; const GAS float* W = (const GAS float*)arg_in(wd[w].in) + (size_t)l * K * N;
          const GAS float* gn = wd[w].gi >= 0 ? (const GAS float*)arg_in(wd[w].gi) + (size_t)l * K : nullptr;
          GAS bf16_t* WT = (GAS bf16_t*)(ws + WS_W + (size_t)l * LAYER_W + wd[w].ow);
          for (long idx = gt; idx < (long)K * N; idx += NT) { const int k = (int)(idx % K), n = (int)(idx / K); const int nr = (w == 0 && n >= IN_SPLIT) ? n + (NPJ - IN_NAT) : n;
              const float v = W[(size_t)k * N + n] * (gn ? gn[k] : 1.0f); WT[(size_t)nr * K + k] = (bf16_t)(cvtpk(v, 0.f) & 0xffffu); } }
      constexpr int ZV2 = (C_GSB - IN_SPLIT) * DM * 2 / 16;
      for (int idx = gt; idx < DEPTH * ZV2; idx += NT) { const int l = idx / ZV2, r = idx % ZV2;
          *(GAS u32x4*)(ws + WS_W + (size_t)l * LAYER_W + OW_IN + (size_t)IN_SPLIT * DM * 2 + (size_t)r * 16) = (u32x4){0u, 0u, 0u, 0u}; }
      return; }
#endif
    { const float* c = (const float*)arg_in(1); const float* w_ada = (const float*)arg_in(3); const float* b_ada = (const float*)arg_in(4); float* mods = (float*)(ws + WS_MODS);
      LAS float* cact = (LAS float*)F.lds; LAS float* red = (LAS float*)(F.lds + 32768);
      for (int i = F.tid; i < NB * DM; i += 512) { const float v = ((const GAS float*)c)[i]; cact[i] = v / (1.0f + __expf(-v)); }
      __syncthreads();
      const int n = F.tid & 63, kc = F.tid >> 6;
      for (int item = blockIdx.x; item < DEPTH * 96; item += F.G) {
          const int l = item / 96, n0 = (item % 96) * 64;
          const float* w = w_ada + ((size_t)l * DM + kc * 128) * (6 * DM) + n0 + n;
          float acc[8];
#pragma unroll
          for (int b = 0; b < 8; ++b) acc[b] = 0.f;
#pragma unroll 4
          for (int k = 0; k < 128; ++k) { const float wv = ((const GAS float*)w)[(size_t)k * (6 * DM)];
#pragma unroll
              for (int b = 0; b < 8; ++b) acc[b] += wv * cact[b * DM + kc * 128 + k]; }
#pragma unroll
          for (int b = 0; b < 8; ++b) red[(kc * 8 + b) * 64 + n] = acc[b];
          __syncthreads();
          { const int b = F.tid >> 6; float s = ((const GAS float*)b_ada)[l * (6 * DM) + n0 + n];
#pragma unroll
            for (int k2 = 0; k2 < 8; ++k2) s += red[(k2 * 8 + b) * 64 + n];
            ((GAS float*)mods)[((size_t)l * NB + b) * (6 * DM) + n0 + n] = s; }
          __syncthreads();
      } }
    { LAS float* scr = (LAS float*)(F.lds + F.wave * 16384);
      const int gw = F.vcu * NWAVES + F.wave, NGW = F.G * NWAVES;
      constexpr int I_IN = (DM / 64) * (IN_NAT / 32), I_QUP = (QRANK / 64) * (QFULL / 32), I_KVUP = (KVRANK / 64) * (KVW / 32), I_SB = (512 / 64) * (DM / 32), I_MIX = (DM / 64) * (DM / 32),
                    I_UP = (DM / 64) * (FF / 32), I_DOWN = (FF / 64) * (DM / 32), I_LAYER = I_IN + I_QUP + I_KVUP + 2 * I_SB + I_MIX + I_UP + I_DOWN;
      for (int it = gw; it < DEPTH * I_LAYER; it += NGW) {
          const int l = it / I_LAYER; int r = it % I_LAYER;
          unsigned char* wl = ws + WS_W + (size_t)l * LAYER_W;
          if (r < I_IN) { transpose_item((const float*)arg_in(6) + (size_t)l * DM * IN_NAT, DM, IN_NAT, (bf16_t*)(wl + OW_IN), IN_SPLIT, NPJ - IN_NAT, nullptr, scr, r, F.lane); continue; } r -= I_IN;
          if (r < I_QUP) { transpose_item((const float*)arg_in(8) + (size_t)l * QRANK * QFULL, QRANK, QFULL, (bf16_t*)(wl + OW_QUP), 1 << 30, 0, (const float*)arg_in(7) + l * QRANK, scr, r, F.lane); continue; } r -= I_QUP;
          if (r < I_KVUP) { transpose_item((const float*)arg_in(10) + (size_t)l * KVRANK * KVW, KVRANK, KVW, (bf16_t*)(wl + OW_KVUP), 1 << 30, 0, (const float*)arg_in(9) + l * KVRANK, scr, r, F.lane); continue; } r -= I_KVUP;
          if (r < I_SB) { transpose_item((const float*)arg_in(11) + (size_t)l * 512 * DM, 512, DM, (bf16_t*)(wl + OW_SB), 1 << 30, 0, nullptr, scr, r, F.lane); continue; } r -= I_SB;
          if (r < I_SB) { transpose_item((const float*)arg_in(12) + (size_t)l * 512 * DM, 512, DM, (bf16_t*)(wl + OW_MLA), 1 << 30, 0, nullptr, scr, r, F.lane); continue; } r -= I_SB;
          if (r < I_MIX) { transpose_item((const float*)arg_in(13) + (size_t)l * DM * DM, DM, DM, (bf16_t*)(wl + OW_MIX), 1 << 30, 0, nullptr, scr, r, F.lane); continue; } r -= I_MIX;
          if (r < I_UP) { transpose_item((const float*)arg_in(15) + (size_t)l * DM * FF, DM, FF, (bf16_t*)(wl + OW_UP), 1 << 30, 0, nullptr, scr, r, F.lane); continue; } r -= I_UP;
          transpose_item((const float*)arg_in(16) + (size_t)l * FF * DM, FF, DM, (bf16_t*)(wl + OW_DOWN), 1 << 30, 0, nullptr, scr, r, F.lane);
      }
      constexpr int ZV = (C_GSB - IN_SPLIT) * DM * 2 / 16;
      for (int idx = gt; idx < DEPTH * ZV; idx += NT) { const int l = idx / ZV, r = idx % ZV;
          *(GAS u32x4*)(ws + WS_W + (size_t)l * LAYER_W + OW_IN + (size_t)IN_SPLIT * DM * 2 + (size_t)r * 16) = (u32x4){0u, 0u, 0u, 0u}; }
    }
}

__device__ __forceinline__ void phase_norm(const Frame& F, const float* xsrc, const float* g, const float* mods_l, int shift_part, bf16_t* H) {
    const int gw = F.vcu * NWAVES + F.wave, NGW = F.G * NWAVES;
    for (int m = gw; m < MTOK; m += NGW) {
        const GAS f32x4* xr = (const GAS f32x4*)(xsrc + (size_t)m * DM) + F.lane;
        f32x4 v[4]; float ss = 0.f;
#pragma unroll
        for (int j = 0; j < 4; ++j) { v[j] = xr[64 * j]; ss += (v[j][0] * v[j][0] + v[j][1] * v[j][1]) + (v[j][2] * v[j][2] + v[j][3] * v[j][3]); }
        const float rs = 1.0f / sqrtf(wave_sum(ss) * (1.0f / DM) + NORM_EPS);
        const float* sh = mods_l + (size_t)(m >> 11) * (6 * DM) + shift_part * DM; const float* sc = sh + DM;
#pragma unroll
        for (int j = 0; j < 4; ++j) { const int c = 4 * F.lane + 256 * j;
            const f32x4 gg = *(const GAS f32x4*)(g + c), s1 = *(const GAS f32x4*)(sc + c), s0 = *(const GAS f32x4*)(sh + c);
            st4bf(H + (size_t)m * DM + c, (v[j] * rs) * gg * (1.0f + s1) + s0); }
    }
}
__device__ __forceinline__ void phase_lat(const Frame& F, const bf16_t* P, const float* cosT, const float* sinT, bf16_t* QN, bf16_t* KVN, bf16_t* KPE) {
    const int gw = F.vcu * NWAVES + F.wave, NGW = F.G * NWAVES, lane = F.lane;
    for (int m = gw; m < MTOK; m += NGW) {
        const bf16_t* pr = P + (size_t)m * NPJ;
        { u32x4 w = {0u, 0u, 0u, 0u}; if (lane < 48) w = *(const GAS u32x4*)(pr + C_QLAT + lane * 8);
          float f[8]; float ss = 0.f;
#pragma unroll
          for (int e = 0; e < 4; ++e) { f[2 * e] = up_lo(w[e]); f[2 * e + 1] = up_hi(w[e]); ss += f[2 * e] * f[2 * e] + f[2 * e + 1] * f[2 * e + 1]; }
          const float rs = 1.0f / sqrtf(wave_sum(ss) * (1.0f / QRANK) + NORM_EPS);
          if (lane < 48) { u32x4 o;
#pragma unroll
              for (int e = 0; e < 4; ++e) o[e] = cvtpk(f[2 * e] * rs, f[2 * e + 1] * rs);
              *(GAS u32x4*)(QN + (size_t)m * QRANK + lane * 8) = o; } }
        { u32x4 w = {0u, 0u, 0u, 0u}; if (lane < 32) w = *(const GAS u32x4*)(pr + C_KVLAT + lane * 8);
          float f[8]; float ss = 0.f;
#pragma unroll
          for (int e = 0; e < 4; ++e) { f[2 * e] = up_lo(w[e]); f[2 * e + 1] = up_hi(w[e]); ss += f[2 * e] * f[2 * e] + f[2 * e + 1] * f[2 * e + 1]; }
          const float rs = 1.0f / sqrtf(wave_sum(ss) * (1.0f / KVRANK) + NORM_EPS);
          if (lane < 32) { u32x4 o;
#pragma unroll
              for (int e = 0; e < 4; ++e) o[e] = cvtpk(f[2 * e] * rs, f[2 * e + 1] * rs);
              *(GAS u32x4*)(KVN + (size_t)m * KVRANK + lane * 8) = o; } }
        if (lane < 16) { const float t1 = bf2f(((const GAS bf16_t*)pr)[C_KROPE + lane]), t2 = bf2f(((const GAS bf16_t*)pr)[C_KROPE + 16 + lane]); const float cs = ((const GAS float*)cosT)[(size_t)m * 16 + lane], sn = ((const GAS float*)sinT)[(size_t)m * 16 + lane];
            const unsigned o1 = cvtpk(t1 * cs - t2 * sn, 0.f), o2 = cvtpk(t2 * cs + t1 * sn, 0.f);
            ((GAS bf16_t*)KPE)[(size_t)m * 32 + lane] = (bf16_t)(o1 & 0xffffu); ((GAS bf16_t*)KPE)[(size_t)m * 32 + 16 + lane] = (bf16_t)(o2 & 0xffffu); }
    }
}
__device__ __forceinline__ void phase_final(const Frame& F, float* X, const float* g) {
    const int gw = F.vcu * NWAVES + F.wave, NGW = F.G * NWAVES;
    for (int m = gw; m < MTOK; m += NGW) {
        GAS f32x4* xr = (GAS f32x4*)(X + (size_t)m * DM) + F.lane;
        f32x4 v[4]; float ss = 0.f;
#pragma unroll
        for (int j = 0; j < 4; ++j) { v[j] = xr[64 * j]; ss += (v[j][0] * v[j][0] + v[j][1] * v[j][1]) + (v[j][2] * v[j][2] + v[j][3] * v[j][3]); }
        const float rs = 1.0f / sqrtf(wave_sum(ss) * (1.0f / DM) + NORM_EPS);
#pragma unroll
        for (int j = 0; j < 4; ++j) xr[64 * j] = (v[j] * rs) * *(const GAS f32x4*)(g + 4 * F.lane + 256 * j);
    }
}

constexpr int STEPS = 11;
constexpr int N_PHASES = 2 + STEPS * DEPTH;

__global__ void __launch_bounds__(NWAVES * 64, 2) mk_fwd(Args a) {
    extern __shared__ __attribute__((aligned(16))) unsigned char lds_raw[];
    Frame F;
    F.lds = (LAS unsigned char*)lds_raw;
    F.tid = threadIdx.x; F.lane = F.tid & 63; F.wave = __builtin_amdgcn_readfirstlane(F.tid >> 6);
    F.G = gridDim.x; { const int bx = blockIdx.x; F.vcu = (F.G % 8 == 0) ? (bx % 8) * (F.G / 8) + bx / 8 : bx; }
    unsigned char* ws0 = a.ws;
    volatile LAS unsigned* MISC = (volatile LAS unsigned*)(F.lds + MISC_OFF);
    for (int u = F.tid; u < (LDS_BYTES - LDSCTL_OFF) / 4; u += NWAVES * 64) ((LAS unsigned*)(F.lds + LDSCTL_OFF))[u] = 0u;
    __syncthreads();
    const int lo = a.ph_lo, hi = a.ph_hi;
    XcdBarrier bar; bar.bar = (unsigned*)(ws0 + WS_CTL) + CW_BAR; bar.x = 0; bar.st = nullptr;
    if (hi - lo > 1) bar = xcd_barrier_post((unsigned*)(ws0 + WS_CTL) + CW_BAR, MISC + 8);

#define cosT ((const float*)(ws + WS_COS))
#define sinT ((const float*)(ws + WS_SIN))
#define P    ((bf16_t*)(ws + WS_P))
#define U    ((bf16_t*)(ws + WS_P))
#define QF   ((bf16_t*)(ws + WS_QF))
#define KV   ((bf16_t*)(ws + WS_KV))
#define MG   ((bf16_t*)(ws + WS_QF))
#define QN   ((bf16_t*)(ws + WS_QN))
#define KVN  ((bf16_t*)(ws + WS_KVN))
#define KPE  ((bf16_t*)(ws + WS_KPE))
#define H    ((bf16_t*)(ws + WS_H))
#define OSB  ((bf16_t*)(ws + WS_H))
#define OMLA ((bf16_t*)(ws + WS_H) + (size_t)MTOK * 512)
#define X    (a.out)
#define wl (ws + WS_W + (size_t)l * LAYER_W)
#define mods_l ((const float*)(ws + WS_MODS) + (size_t)l * NB * (6 * DM))
#define xin ((l == 0) ? (const float*)arg_in(0) : (const float*)X)

#define REFRESH() { unsigned z_ = 0u; asm volatile("" : "+v"(z_)); const int l_ = (int)__builtin_amdgcn_mbcnt_hi(~0u, __builtin_amdgcn_mbcnt_lo(~0u, z_)); F.lane = l_; F.tid = F.wave * 64 + l_; }
#define FRESH() int bx_; unsigned char* ws; { unsigned z_ = 0u; asm volatile("" : "+v"(z_)); const int l_ = (int)__builtin_amdgcn_mbcnt_hi(~0u, __builtin_amdgcn_mbcnt_lo(~0u, z_)); F.lane = l_; F.tid = F.wave * 64 + l_; \
        bx_ = blockIdx.x; asm volatile("" : "+s"(bx_)); ws = ws0; asm volatile("" : "+s"(ws)); }
    for (int ph = lo; ph < hi; ++ph) {
        const int l = (ph - 1) / STEPS, t = (ph == 0) ? -1 : (ph == N_PHASES - 1) ? -2 : (ph - 1) % STEPS;
        bool skip_bar = false;
        if (t == -1) {
            FRESH(); (void)bx_;
            phase_p0(F, ws);
        } else if (t == -2) {
            FRESH(); (void)bx_; (void)ws;
            phase_final(F, X, (const float*)arg_in(17));
        } else if (t == 0) {
            FRESH(); (void)bx_;
            phase_norm(F, xin, (const float*)arg_in(5) + l * DM, mods_l, 0, H);
        } else if (t == 8) {
            FRESH(); (void)bx_;
            phase_norm(F, X, (const float*)arg_in(14) + l * DM, mods_l, 3, H);
        } else if (t == 2) {
            FRESH(); (void)bx_;
            phase_lat(F, P, cosT, sinT, QN, KVN, KPE);
        } else if (t == 5) {
            FRESH(); (void)bx_;
#if DBG_NAIVE_SB
            naive_attn<false>(blockIdx.x * 512 + F.tid, F.G * 512, P, NPJ, 64, P, NPJ, 64, C_KSB, KPE, P, NPJ, 64, C_VSB, OSB);
#endif
#if DBG_NAIVE_MLA
            naive_attn<true>(blockIdx.x * 512 + F.tid, F.G * 512, QF, QFULL, 96, KV, KVW, 128, 0, KPE, KV, KVW, 128, 64, OMLA);
#endif
            for (int pi = F.vcu; pi < 256; pi += F.G) {
                const int bh = pi >> 2, s = pi & 3, b = bh >> 3, h = bh & 7;
#if !DBG_NAIVE_SB
#pragma unroll 1
                for (int k = 0; k < 2; ++k) { const int qb = k ? 7 - s : s;
                    attn_unit<false>(F.lds, F.tid, b, qb, P, NPJ, C_QSB + h * 64, P, NPJ, C_KSB + h * 64, KPE, P, NPJ, C_VSB + h * 64, OSB, 512, h * 64); }
#endif
#if !DBG_NAIVE_MLA
#pragma unroll 1
                for (int k = 0; k < 2; ++k) { const int qb = k ? 7 - s : s;
                    attn_unit<true>(F.lds, F.tid, b, qb, QF, QFULL, h * 96, KV, KVW, h * 128, KPE, KV, KVW, h * 128 + 64, OMLA, 512, h * 64); }
#endif
                (void)b; (void)h; (void)s;
            }
        } else {
            FRESH();
            pg8::Gemm g; pg8::Order S; EpiAll E; int N = DM, crot = 0;
            g.A2 = nullptr; g.Bt2 = nullptr; S.pair = 0; E.p1 = nullptr; E.p2 = nullptr;
            if (t == 1) {
                g.A = H; g.Bt = (const bf16_t*)(wl + OW_IN); g.lda = DM; g.ldb = DM; g.K = DM; N = NPJ; E.kind = 0; E.o = P;
            } else if (t == 3) {
                g.A = QN; g.Bt = (const bf16_t*)(wl + OW_QUP); g.lda = QRANK; g.ldb = QRANK; g.K = QRANK; N = QFULL; E.kind = 1; E.o = QF; E.p1 = cosT; E.p2 = sinT; skip_bar = true;
            } else if (t == 4) {
                g.A = KVN; g.Bt = (const bf16_t*)(wl + OW_KVUP); g.lda = KVRANK; g.ldb = KVRANK; g.K = KVRANK; N = KVW; E.kind = 2; E.o = KV; crot = 192;
            } else if (t == 6) {
                g.A = OSB; g.Bt = (const bf16_t*)(wl + OW_SB); g.A2 = OMLA; g.Bt2 = (const bf16_t*)(wl + OW_MLA); g.lda = 512; g.ldb = 512; g.K = 512; S.pair = 1; E.kind = 3; E.o = MG; E.p1 = P;
            } else if (t == 9) {
                g.A = H; g.Bt = (const bf16_t*)(wl + OW_UP); g.lda = DM; g.ldb = DM; g.K = DM; N = FF; E.kind = 5; E.o = U;
            } else {
                const bool isF = (t == 10);
                g.A = isF ? U : MG; g.Bt = (const bf16_t*)(wl + (isF ? OW_DOWN : OW_MIX)); g.lda = isF ? FF : DM; g.ldb = g.lda; g.K = g.lda;
                E.kind = 4; E.o = X; E.p1 = isF ? (const float*)X : xin; E.p2 = mods_l + (isF ? 5 : 2) * DM;
            }
            S.s.init(MTOK, N, F.G, (int)(((unsigned)bx_ + (unsigned)crot) % (unsigned)F.G));
            if ((DBG_NAIVE_GEMM >> t) & 1) E.naive(blockIdx.x * 512 + F.tid, F.G * 512, g, N, S.pair ? 2 : 1);
            else pg8::gemm_phase<EpiAll, pg8::Order, true>(F.lds, F.tid, g, S, E);
        }
        if (ph + 1 < hi && !skip_bar) xcd_barrier(bar);
    }
}

extern "C" void kernel_launch(void* const* d_in, const int* in_sizes, int n_in, void* d_out, int out_size, void* d_ws, size_t ws_size, hipStream_t stream) {
    static int grid = 0;
    if (grid == 0) {
        if (n_in != 18 || in_sizes[0] != MTOK * DM || out_size != MTOK * DM || ws_size < WS_END) {
            fprintf(stderr, "kernel_launch: unexpected shapes (n_in %d, in0 %d, out %d, ws %zu); nothing launched\n", n_in, n_in > 0 ? in_sizes[0] : -1, out_size, ws_size); grid = -1; return; }
        int dev = 0, cus = 0, per_cu = 0;
        if (hipGetDevice(&dev) != hipSuccess || hipDeviceGetAttribute(&cus, hipDeviceAttributeMultiprocessorCount, dev) != hipSuccess) { grid = -1; return; }
        if (hipFuncSetAttribute((const void*)mk_fwd, hipFuncAttributeMaxDynamicSharedMemorySize, LDS_BYTES) != hipSuccess) { fprintf(stderr, "kernel_launch: hipFuncSetAttribute failed\n"); grid = -1; return; }
        if (hipOccupancyMaxActiveBlocksPerMultiprocessor(&per_cu, (const void*)mk_fwd, NWAVES * 64, LDS_BYTES) != hipSuccess || per_cu < 1) {
            fprintf(stderr, "kernel_launch: occupancy query reports %d workgroups per CU; nothing launched\n", per_cu); (void)hipGetLastError(); grid = -1; return; }
        grid = cus;
    }
    if (grid < 0) return;
    (void)hipMemsetAsync((char*)d_ws + WS_CTL, 0, CTL_ZERO_BYTES, stream);
    Args a{};
    for (int i = 0; i < 18; ++i) a.in[i] = d_in[i];
    a.out = (float*)d_out; a.ws = (unsigned char*)d_ws;
#if MK_N_LAUNCHES == 1
    a.ph_lo = 0; a.ph_hi = N_PHASES;
    void* kargs[] = {&a};
    hipError_t e = hipLaunchCooperativeKernel((const void*)mk_fwd, dim3(grid), dim3(NWAVES * 64), kargs, LDS_BYTES, stream);
    if (e != hipSuccess) fprintf(stderr, "kernel_launch: cooperative launch failed: %s (grid %d)\n", hipGetErrorString(e), grid);
#else
    for (int ph = 0; ph < N_PHASES; ++ph) {
        a.ph_lo = ph; a.ph_hi = ph + 1;
        hipLaunchKernelGGL(mk_fwd, dim3(grid), dim3(NWAVES * 64), LDS_BYTES, stream, a);
    }
#endif
}
```

```cpp
#include <hip/hip_runtime.h>
#include <cstdio>
#include <cstdint>

#ifndef MK_N_LAUNCHES
#define MK_N_LAUNCHES 1
#endif

#define LAS __attribute__((address_space(3)))
#define GAS __attribute__((address_space(1)))
typedef unsigned short bf16_t;
typedef short bf16x8 __attribute__((ext_vector_type(8)));
typedef short s16x4 __attribute__((ext_vector_type(4)));
typedef float f32x2 __attribute__((ext_vector_type(2)));
typedef float f32x4 __attribute__((ext_vector_type(4)));
typedef float f32x16 __attribute__((ext_vector_type(16)));
typedef unsigned u32x2 __attribute__((ext_vector_type(2)));
typedef unsigned u32x4 __attribute__((ext_vector_type(4)));
typedef __bf16 bf16x2_t __attribute__((ext_vector_type(2)));

constexpr int DM = 1024, NB = 8, SEQ = 2048, MTOK = NB * SEQ, DEPTH = 4, FF = 4096;
constexpr int NPJ = 4352;
constexpr int C_QSB = 0, C_KSB = 512, C_VSB = 1024, C_QLAT = 1536, C_KVLAT = 1920, C_KROPE = 2176, C_GSB = 2304, C_GMLA = 3328;
constexpr int IN_NAT = 4256, IN_SPLIT = 2208;
constexpr int QRANK = 384, KVRANK = 256, QFULL = 768, KVW = 1024;
constexpr float NORM_EPS = 1e-6f;
constexpr float LOG2E = 1.4426950408889634f;
constexpr float C2SB = 0.125f * LOG2E;
constexpr float C2MLA = 0.10206207261596577f * LOG2E;

constexpr size_t MiB = 1u << 20;
constexpr size_t WS_CTL = 0, CTL_ZERO_BYTES = 1 * MiB;
constexpr size_t WS_COS = 1 * MiB, WS_SIN = 2 * MiB;
constexpr size_t WS_MODS = 3 * MiB;
constexpr size_t WS_XSTAT = 3 * MiB + 786432;
constexpr size_t WS_W = 4 * MiB;
constexpr size_t OW_IN = 0, OW_QUP = OW_IN + (size_t)NPJ * DM * 2, OW_KVUP = OW_QUP + (size_t)QFULL * QRANK * 2, OW_SB = OW_KVUP + (size_t)KVW * KVRANK * 2,
                 OW_MLA = OW_SB + (size_t)DM * 512 * 2, OW_MIX = OW_MLA + (size_t)DM * 512 * 2, OW_UP = OW_MIX + (size_t)DM * DM * 2, OW_DOWN = OW_UP + (size_t)FF * DM * 2,
                 LAYER_W = OW_DOWN + (size_t)DM * FF * 2;
constexpr size_t WS_P = 123 * MiB;
constexpr size_t WS_QF = 259 * MiB;
constexpr size_t WS_KV = 283 * MiB;
constexpr size_t WS_LSTAT = 315 * MiB;
constexpr size_t WS_SV1 = 317 * MiB;
constexpr size_t WS_SV2 = 318 * MiB;
constexpr size_t WS_KPE = 335 * MiB;
constexpr size_t WS_H = 336 * MiB;
constexpr size_t WS_END = 368 * MiB;
static_assert(WS_W + DEPTH * LAYER_W <= WS_P, "weights fit");

constexpr int RING_BYTES = 131072;
constexpr int LDSCTL_OFF = RING_BYTES, MISC_OFF = LDSCTL_OFF + 320;
constexpr int LDS_BYTES = 147456;
constexpr int NWAVES = 8;

#ifndef USE_F16
#define USE_F16 1
#endif
typedef _Float16 half2_t __attribute__((ext_vector_type(2)));
typedef _Float16 half8_t __attribute__((ext_vector_type(8)));
#if USE_F16
__device__ __forceinline__ unsigned cvtpk(float lo, float hi) { f32x2 v = {lo, hi}; half2_t b = __builtin_convertvector(v, half2_t); return __builtin_bit_cast(unsigned, b); }
__device__ __forceinline__ float bf2f(unsigned short h) { return (float)__builtin_bit_cast(_Float16, h); }
__device__ __forceinline__ float up_lo(unsigned w) { return (float)__builtin_bit_cast(half2_t, w)[0]; }
__device__ __forceinline__ float up_hi(unsigned w) { return (float)__builtin_bit_cast(half2_t, w)[1]; }
#define MFMA16(a, b, c) __builtin_amdgcn_mfma_f32_16x16x32_f16(__builtin_bit_cast(half8_t, a), __builtin_bit_cast(half8_t, b), c, 0, 0, 0)
#define MFMA32(a, b, c) __builtin_amdgcn_mfma_f32_32x32x16_f16(__builtin_bit_cast(half8_t, a), __builtin_bit_cast(half8_t, b), c, 0, 0, 0)
#else
__device__ __forceinline__ unsigned cvtpk(float lo, float hi) { f32x2 v = {lo, hi}; bf16x2_t b = __builtin_convertvector(v, bf16x2_t); return __builtin_bit_cast(unsigned, b); }
__device__ __forceinline__ float bf2f(unsigned short h) { return __builtin_bit_cast(float, (unsigned)h << 16); }
__device__ __forceinline__ float up_lo(unsigned w) { return __builtin_bit_cast(float, w << 16); }
__device__ __forceinline__ float up_hi(unsigned w) { return __builtin_bit_cast(float, w & 0xffff0000u); }
#define MFMA16(a, b, c) __builtin_amdgcn_mfma_f32_16x16x32_bf16(a, b, c, 0, 0, 0)
#endif
__device__ __forceinline__ void st4bf(bf16_t* p, f32x4 v) { u32x2 w; w.x = cvtpk(v[0], v[1]); w.y = cvtpk(v[2], v[3]); *(GAS u32x2*)p = w; }
__device__ __forceinline__ f32x4 bf4(u32x2 w) { f32x4 r; r[0] = up_lo(w.x); r[1] = up_hi(w.x); r[2] = up_lo(w.y); r[3] = up_hi(w.y); return r; }
__device__ __forceinline__ f32x4 ld4bf(const bf16_t* p) { return bf4(*(const GAS u32x2*)p); }
#define swz_xor(v, pat) __builtin_bit_cast(float, __builtin_amdgcn_ds_swizzle(__builtin_bit_cast(int, (float)(v)), (pat)))
__device__ __forceinline__ void swap32(float& a, float& b) { asm volatile("s_nop 1\n\tv_permlane32_swap_b32 %0, %1" : "+v"(a), "+v"(b)); }
__device__ __forceinline__ float sum_halves(float v) { float a = v, b = v; swap32(a, b); return a + b; }
__device__ __forceinline__ float max_halves(float v) { float a = v, b = v; swap32(a, b); return fmaxf(a, b); }
__device__ __forceinline__ float other_half(float v, int hi) { float a = v, b = v; swap32(a, b); return hi ? a : b; }
#ifndef DBG_SHFL_SUM
#define DBG_SHFL_SUM 0
#endif
__device__ __forceinline__ float wave_sum(float v) {
#if DBG_SHFL_SUM
#pragma unroll
    for (int o = 1; o < 64; o <<= 1) v += __shfl_xor(v, o);
    return v;
#else
    v += swz_xor(v, (1 << 10) | 0x1f); v += swz_xor(v, (2 << 10) | 0x1f); v += swz_xor(v, (4 << 10) | 0x1f); v += swz_xor(v, (8 << 10) | 0x1f); v += swz_xor(v, (16 << 10) | 0x1f);
    return sum_halves(v);
#endif
}
#define LDS_WAIT() asm volatile("s_waitcnt lgkmcnt(0)" ::: "memory")
#define VM_WAIT() asm volatile("s_waitcnt vmcnt(0)" ::: "memory")

namespace pg8 {
constexpr int BM = 256, BK = 64, HALF = 128, HTB = HALF * BK * 2, STAGE_BYTES = 8 * HTB, NXCD = 8, WGM = 8;
__host__ __device__ __forceinline__ int lds_byte(int r, int c) { const int st = (r >> 4) * 2 + (c >> 5), rr = r & 15, cc = c & 31, ob = rr * 64 + cc * 2; return st * 1024 + (ob ^ (((ob >> 9) & 1) << 5)); }
__host__ __device__ __forceinline__ void stage_rc(int b, int& R, int& C) { const int st = b / 1024, sb = b % 1024, swz = sb ^ (((sb >> 9) & 1) << 5); R = (st >> 1) * 16 + swz / 64; C = (st & 1) * 32 + (swz % 64) / 2; }

struct Unit { int pm, pn, z; };
struct Gemm { const bf16_t* A; const bf16_t* Bt; const bf16_t* A2; const bf16_t* Bt2; int lda, ldb, K; };

struct StaticOrder {
    int nM, nN, nwg, G, c;
    __host__ __device__ void init(int M, int N, int G_, int c_) { nM = M / BM; nN = N / BM; nwg = nM * nN; G = G_; c = c_; }
    __host__ __device__ bool next(int i, Unit& u) const {
        const long L = (long)i * G + c; if (L >= nwg) return false;
        int wgid = (int)L; { const int q = nwg / NXCD, r = nwg % NXCD, xcd = wgid % NXCD, off = wgid / NXCD; wgid = (xcd < r ? xcd * (q + 1) : r * (q + 1) + (xcd - r) * q) + off; }
        const int nig = WGM * nN, gid = wgid / nig, fm = gid * WGM, gsz = (nM - fm) < WGM ? (nM - fm) : WGM;
        u.pm = fm + ((wgid % nig) % gsz); u.pn = (wgid % nig) / gsz; u.z = 0; return true;
    }
};
struct Order {
    StaticOrder s; int pair;
    __host__ __device__ bool next(int i, Unit& u) const { if (!s.next(pair ? (i >> 1) : i, u)) return false; u.z = pair ? (i & 1) : 0; return true; }
};

template <class F> struct Epi {
    F f;
    __device__ __forceinline__ void operator()(const f32x4 (&acc)[2][2][4][2], const Unit& u, int wr, int wc, int fr, int fq) const {
        { unsigned z_ = 0u; asm volatile("" : "+v"(z_)); const int l_ = (int)__builtin_amdgcn_mbcnt_hi(~0u, __builtin_amdgcn_mbcnt_lo(~0u, z_)); fr = l_ & 15; fq = l_ >> 4; }
#pragma unroll
        for (int bj = 0; bj < 2; ++bj) {
            const int col = u.pn * BM + bj * HALF + wc * 32 + 4 * fq;
            const int row0 = u.pm * BM + wr * 64 + fr;
            const typename F::Ctx cx = f.prep(u, col);
            typename F::Ld ld = f.load(cx, u, row0, col);
#pragma unroll
            for (int it = 0; it < 8; ++it) {
                const int ai = it >> 2, m = it & 3, row = row0 + ai * HALF + m * 16;
                typename F::Ld nl = ld;
                if (it < 7) nl = f.load(cx, u, row0 + ((it + 1) >> 2) * HALF + ((it + 1) & 3) * 16, col);
                f.finish(cx, u, row, col, ld, acc[ai][bj][m][0], acc[ai][bj][m][1], fq);
                asm volatile("" ::: "memory");
                ld = nl;
            }
        }
        f.post(u, wr * 4 + wc, fr + 16 * fq);
    }
};

template <class EpiT, class Sched, bool ALIGN_EPI>
__device__ __forceinline__ void gemm_phase(LAS unsigned char* lds, int tid, const Gemm g, const Sched& S, const EpiT& E) {
    asm volatile("" : "+v"(tid));
    const int wid = __builtin_amdgcn_readfirstlane(tid >> 6), lane = tid & 63, wr = wid >> 2, wc = wid & 3, fr = lane & 15, fq = lane >> 4;
    const int K = g.K, nt = K / BK;
    unsigned voffA[2], voffB[2];
#pragma unroll
    for (int i = 0; i < 2; ++i) { int R, C; stage_rc(tid * 16 + i * 8192, R, C);
        voffA[i] = (unsigned)(R * g.lda + C) * 2u; voffB[i] = (unsigned)(R * g.ldb + C) * 2u; }
    const size_t kstep = (size_t)(BK * 2);
    const size_t hstepA = (size_t)HALF * g.lda * 2, hstepB = (size_t)HALF * g.ldb * 2;
    const size_t tstepA = 2 * hstepA, tstepB = 2 * hstepB;
    const unsigned ldsw = (unsigned)wid * 1024u;
    const int aoff = lds_byte(wr * 64 + fr, fq * 8), boff = lds_byte(wc * 32 + fr, fq * 8);
#define PG8_SA(b, h) (((b) * 2 + (h)) * HTB)
#define PG8_SB(b, h) ((4 + (b) * 2 + (h)) * HTB)
#define PG8_STAGE(bufoff, gbase, voff) do { _Pragma("unroll") for (int _i = 0; _i < 2; ++_i) \
        __builtin_amdgcn_global_load_lds((const unsigned*)((const char*)(gbase) + (voff)[_i]), (LAS unsigned*)(lds + (bufoff) + ldsw + _i * 8192), 16, 0, 0); } while (0)
#define PG8_LDA(dst, b, h) do { _Pragma("unroll") for (int m = 0; m < 4; ++m) _Pragma("unroll") for (int k = 0; k < 2; ++k) dst[m][k] = *(const LAS bf16x8*)(lds + PG8_SA(b, h) + aoff + m * 2048 + k * 1024); } while (0)
#define PG8_LDB(dst, b, h) do { _Pragma("unroll") for (int n = 0; n < 2; ++n) _Pragma("unroll") for (int k = 0; k < 2; ++k) dst[n][k] = *(const LAS bf16x8*)(lds + PG8_SB(b, h) + boff + n * 2048 + k * 1024); } while (0)
#define PG8_MMA(ai, bj, At, Bt) do { __builtin_amdgcn_s_setprio(1); _Pragma("unroll") for (int m = 0; m < 4; ++m) _Pragma("unroll") for (int n = 0; n < 2; ++n) _Pragma("unroll") for (int k = 0; k < 2; ++k) \
        acc[ai][bj][m][n] = MFMA16(Bt[n][k], At[m][k], acc[ai][bj][m][n]); __builtin_amdgcn_s_setprio(0); } while (0)
#define PG8_WAIT_V(n) asm volatile("s_waitcnt vmcnt(" #n ")" ::: "memory")
#define PG8_WAIT_L(n) asm volatile("s_waitcnt lgkmcnt(" #n ")" ::: "memory")
#define PG8_BAR __builtin_amdgcn_s_barrier()
#define PG8_SCHED __builtin_amdgcn_sched_barrier(0)
    Unit cur, nxt; int ui = 0;
    if (!S.next(0, cur)) return;
    f32x4 acc[2][2][4][2];
    { float zf = 0.f; asm volatile("" : "+v"(zf));
#pragma unroll
    for (int a = 0; a < 2; ++a)
#pragma unroll
        for (int b = 0; b < 2; ++b)
#pragma unroll
            for (int m = 0; m < 4; ++m)
#pragma unroll
                for (int n = 0; n < 2; ++n) acc[a][b][m][n] = (f32x4){zf, zf, zf, zf}; }
    bf16x8 At[4][2], B0[2][2], B1[2][2];
    const char* cA = (const char*)(cur.z ? g.A2 : g.A) + (size_t)cur.pm * tstepA; const char* cB = (const char*)(cur.z ? g.Bt2 : g.Bt) + (size_t)cur.pn * tstepB;
    PG8_STAGE(PG8_SB(0, 0), cB, voffB); PG8_STAGE(PG8_SB(0, 1), cB + hstepB, voffB); PG8_STAGE(PG8_SA(0, 0), cA, voffA); PG8_STAGE(PG8_SA(0, 1), cA + hstepA, voffA);
    if (wr == 1) PG8_BAR;
    PG8_WAIT_V(2); PG8_BAR;
    PG8_STAGE(PG8_SB(1, 0), cB + kstep, voffB); PG8_STAGE(PG8_SA(1, 0), cA + kstep, voffA); PG8_STAGE(PG8_SB(1, 1), cB + hstepB + kstep, voffB);
    PG8_WAIT_V(6); PG8_BAR;
    for (;;) {
        const bool has_next = S.next(ui + 1, nxt);
        const char* nA = has_next ? (const char*)(nxt.z ? g.A2 : g.A) + (size_t)nxt.pm * tstepA : cA; const char* nB = has_next ? (const char*)(nxt.z ? g.Bt2 : g.Bt) + (size_t)nxt.pn * tstepB : cB;
        for (int t = 0; t < nt; t += 2) {
            const bool last = (t == nt - 2);
            const char* a1 = cA + (size_t)(t + 1) * kstep;
            const char* a2 = last ? nA : cA + (size_t)(t + 2) * kstep; const char* b2 = last ? nB : cB + (size_t)(t + 2) * kstep;
            const char* a3 = a2 + kstep; const char* b3 = b2 + kstep;
            PG8_LDB(B0, 0, 0); PG8_LDB(B1, 0, 1); PG8_SCHED; PG8_LDA(At, 0, 0); PG8_STAGE(PG8_SA(1, 1), a1 + hstepA, voffA);
            PG8_WAIT_V(8); PG8_WAIT_L(0); PG8_BAR; PG8_MMA(0, 0, At, B0); PG8_MMA(0, 1, At, B1); PG8_BAR; PG8_SCHED;
            PG8_LDA(At, 0, 1); PG8_STAGE(PG8_SB(0, 0), b2, voffB); PG8_STAGE(PG8_SB(0, 1), b2 + hstepB, voffB); PG8_STAGE(PG8_SA(0, 0), a2, voffA);
            PG8_WAIT_V(8); PG8_WAIT_L(0); PG8_BAR; PG8_MMA(1, 0, At, B0); PG8_MMA(1, 1, At, B1); PG8_BAR; PG8_SCHED;
            PG8_LDB(B0, 1, 0); PG8_LDB(B1, 1, 1); PG8_SCHED; PG8_LDA(At, 1, 0); PG8_STAGE(PG8_SA(0, 1), a2 + hstepA, voffA);
            PG8_WAIT_V(8); PG8_WAIT_L(0); PG8_BAR; PG8_MMA(0, 0, At, B0); PG8_MMA(0, 1, At, B1); PG8_BAR; PG8_SCHED;
            PG8_LDA(At, 1, 1); PG8_STAGE(PG8_SB(1, 0), b3, voffB); PG8_STAGE(PG8_SB(1, 1), b3 + hstepB, voffB); PG8_STAGE(PG8_SA(1, 0), a3, voffA);
            PG8_WAIT_V(8); PG8_WAIT_L(0); PG8_BAR; PG8_MMA(1, 0, At, B0); PG8_MMA(1, 1, At, B1); PG8_BAR; PG8_SCHED;
        }
        if constexpr (ALIGN_EPI) { if (wr == 0) PG8_BAR; }
        E(acc, cur, wr, wc, fr, fq);
        if (!has_next) break;
        { float zf = 0.f; asm volatile("" : "+v"(zf));
#pragma unroll
        for (int a = 0; a < 2; ++a)
#pragma unroll
            for (int b = 0; b < 2; ++b)
#pragma unroll
                for (int m = 0; m < 4; ++m)
#pragma unroll
                    for (int n = 0; n < 2; ++n) acc[a][b][m][n] = (f32x4){zf, zf, zf, zf}; }
        cur = nxt; cA = nA; cB = nB; ++ui;
        if constexpr (ALIGN_EPI) { if (wr == 1) PG8_BAR; }
    }
    PG8_WAIT_V(0);
    if constexpr (!ALIGN_EPI) { if (wr == 0) PG8_BAR; }
    PG8_BAR;
#undef PG8_SA
#undef PG8_SB
#undef PG8_STAGE
#undef PG8_LDA
#undef PG8_LDB
#undef PG8_MMA
#undef PG8_WAIT_V
#undef PG8_WAIT_L
#undef PG8_BAR
#undef PG8_SCHED
}
}

__device__ __forceinline__ float sum_fq(float v) { v += swz_xor(v, (16 << 10) | 0x1f); return sum_halves(v); }
__device__ __forceinline__ float dot4(f32x4 a) { return (a[0] * a[0] + a[1] * a[1]) + (a[2] * a[2] + a[3] * a[3]); }
struct LdNone { int d; };
struct F_ProjA {
    bf16_t* P; const float* xstat; const float* sv; float* lstat; bf16_t* kpe; const float* cosT; const float* sinT;
    struct Ctx { float sc; f32x4 s0, s1; int grp; }; struct Ld { f32x4 xs, ct, sn; };
    __device__ __forceinline__ Ctx prep(const pg8::Unit& u, int col) const { Ctx c; c.sc = (u.pn < 2) ? C2SB : 1.0f; const float* sp = sv + (size_t)(u.pm >> 3) * NPJ + col;
        c.s0 = *(const GAS f32x4*)sp; c.s1 = *(const GAS f32x4*)(sp + 16); c.grp = col >> 5; return c; }
    __device__ __forceinline__ Ld load(const Ctx& c, const pg8::Unit&, int row, int col) const { Ld l; l.xs = *(const GAS f32x4*)(xstat + (size_t)row * 4);
        l.ct = l.xs; l.sn = l.xs;
        if (c.grp == (C_KROPE >> 5)) { l.ct = *(const GAS f32x4*)(cosT + (size_t)row * 16 + (col & 15)); l.sn = *(const GAS f32x4*)(sinT + (size_t)row * 16 + (col & 15)); } return l; }
    __device__ __forceinline__ void finish(const Ctx& c, const pg8::Unit&, int row, int col, const Ld& l, f32x4 v0, f32x4 v1, int fq) const {
        const float rs = 1.0f / sqrtf(((l.xs[0] + l.xs[1]) + (l.xs[2] + l.xs[3])) * (1.0f / DM) + NORM_EPS);
        v0 = v0 * rs + c.s0; v1 = v1 * rs + c.s1;
        if (c.grp >= (C_QLAT >> 5) && c.grp < (C_KROPE >> 5)) {
            const float ss = sum_fq(dot4(v0) + dot4(v1));
            if (fq == 0) ((GAS float*)lstat)[(size_t)row * 24 + (c.grp - (C_QLAT >> 5))] = ss;
        }
        if (c.grp == (C_KROPE >> 5)) {
            const f32x4 a = v0 * l.ct - v1 * l.sn, b = v1 * l.ct + v0 * l.sn;
            bf16_t* ko = kpe + (size_t)row * 32 + (col & 15); st4bf(ko, a); st4bf(ko + 16, b);
        }
        bf16_t* o = P + (size_t)row * NPJ + col; st4bf(o, v0 * c.sc); st4bf(o + 16, v1 * c.sc); }
    __device__ __forceinline__ void post(const pg8::Unit&, int, int) const {}
};
struct F_Qup {
    bf16_t* Q; const float* cosT; const float* sinT; const float* lstat;
    struct Ctx { int rope; }; struct Ld { f32x4 a, b, c, ct, st; };
    __device__ __forceinline__ Ctx prep(const pg8::Unit&, int col) const { Ctx c; c.rope = (((col >> 5) % 3) == 2) ? 1 : 0; return c; }
    __device__ __forceinline__ Ld load(const Ctx&, const pg8::Unit&, int row, int col) const { Ld l; const int i0 = col & 15; const float* ls = lstat + (size_t)row * 24;
        l.a = *(const GAS f32x4*)ls; l.b = *(const GAS f32x4*)(ls + 4); l.c = *(const GAS f32x4*)(ls + 8);
        l.ct = *(const GAS f32x4*)(cosT + (size_t)row * 16 + i0); l.st = *(const GAS f32x4*)(sinT + (size_t)row * 16 + i0); return l; }
    __device__ __forceinline__ void finish(const Ctx& c, const pg8::Unit&, int row, int col, const Ld& l, f32x4 v0, f32x4 v1, int) const {
        const f32x4 t = l.a + l.b + l.c; const float rs = 1.0f / sqrtf(((t[0] + t[1]) + (t[2] + t[3])) * (1.0f / QRANK) + NORM_EPS);
        v0 = v0 * rs; v1 = v1 * rs;
        if (c.rope) { const f32x4 a = v0 * l.ct - v1 * l.st, b = v1 * l.ct + v0 * l.st; v0 = a; v1 = b; }
        bf16_t* o = Q + (size_t)row * QFULL + col; st4bf(o, v0 * C2MLA); st4bf(o + 16, v1 * C2MLA); }
    __device__ __forceinline__ void post(const pg8::Unit&, int, int) const {}
};
struct F_Kvup {
    bf16_t* KV; const float* lstat;
    struct Ctx { int d; }; struct Ld { f32x4 a, b; };
    __device__ __forceinline__ Ctx prep(const pg8::Unit&, int) const { Ctx c; c.d = 0; return c; }
    __device__ __forceinline__ Ld load(const Ctx&, const pg8::Unit&, int row, int) const { Ld l; const float* ls = lstat + (size_t)row * 24 + 12; l.a = *(const GAS f32x4*)ls; l.b = *(const GAS f32x4*)(ls + 4); return l; }
    __device__ __forceinline__ void finish(const Ctx&, const pg8::Unit&, int row, int col, const Ld& l, f32x4 v0, f32x4 v1, int) const {
        const f32x4 t = l.a + l.b; const float rs = 1.0f / sqrtf(((t[0] + t[1]) + (t[2] + t[3])) * (1.0f / KVRANK) + NORM_EPS);
        bf16_t* o = KV + (size_t)row * KVW + col; st4bf(o, v0 * rs); st4bf(o + 16, v1 * rs); }
    __device__ __forceinline__ void post(const pg8::Unit&, int, int) const {}
};
__device__ __forceinline__ f32x4 sigmoid4(f32x4 g) { f32x4 r;
#pragma unroll
    for (int i = 0; i < 4; ++i) r[i] = __builtin_amdgcn_rcpf(1.0f + __builtin_amdgcn_exp2f(-LOG2E * g[i]));
    return r; }
struct F_Gate {
    const bf16_t* P; bf16_t* Mg;
    struct Ctx { int goff; }; struct Ld { u32x2 g0, g1, m0, m1; };
    __device__ __forceinline__ Ctx prep(const pg8::Unit& u, int) const { Ctx c; c.goff = u.z ? C_GMLA : C_GSB; return c; }
    __device__ __forceinline__ Ld load(const Ctx& c, const pg8::Unit& u, int row, int col) const { Ld l; const bf16_t* gp = P + (size_t)row * NPJ + c.goff + col;
        l.g0 = *(const GAS u32x2*)gp; l.g1 = *(const GAS u32x2*)(gp + 16); l.m0 = l.g0; l.m1 = l.g1;
        if (u.z) { const bf16_t* o = Mg + (size_t)row * DM + col; l.m0 = *(const GAS u32x2*)o; l.m1 = *(const GAS u32x2*)(o + 16); } return l; }
    __device__ __forceinline__ void finish(const Ctx&, const pg8::Unit& u, int row, int col, const Ld& l, f32x4 v0, f32x4 v1, int) const {
        bf16_t* o = Mg + (size_t)row * DM + col;
        f32x4 r0 = sigmoid4(bf4(l.g0)) * v0, r1 = sigmoid4(bf4(l.g1)) * v1;
        if (u.z) { r0 += bf4(l.m0); r1 += bf4(l.m1); }
        st4bf(o, r0); st4bf(o + 16, r1); }
    __device__ __forceinline__ void post(const pg8::Unit&, int, int) const {}
};
struct F_Resid {
    const float* base; float* X; const float* gate; const float* gn; const float* scn; bf16_t* XG; float* xstat; LAS float* part;
    struct Ctx { f32x4 g0, g1, m0, m1; int slot; }; struct Ld { f32x4 b0, b1; };
    __device__ __forceinline__ Ctx prep(const pg8::Unit& u, int col) const { Ctx c; const size_t bo = (size_t)(u.pm >> 3) * (6 * DM) + col; const float* gp = gate + bo; c.g0 = *(const GAS f32x4*)gp; c.g1 = *(const GAS f32x4*)(gp + 16);
        const float* sp = scn + bo; c.m0 = *(const GAS f32x4*)(gn + col) * (1.0f + *(const GAS f32x4*)sp); c.m1 = *(const GAS f32x4*)(gn + col + 16) * (1.0f + *(const GAS f32x4*)(sp + 16));
        c.slot = (col >> 5) & 7; return c; }
    __device__ __forceinline__ Ld load(const Ctx&, const pg8::Unit&, int row, int col) const { Ld l; const size_t off = (size_t)row * DM + col; l.b0 = *(const GAS f32x4*)(base + off); l.b1 = *(const GAS f32x4*)(base + off + 16); return l; }
    __device__ __forceinline__ void finish(const Ctx& c, const pg8::Unit&, int row, int col, const Ld& l, f32x4 v0, f32x4 v1, int fq) const {
        const size_t off = (size_t)row * DM + col;
        const f32x4 x0 = l.b0 + c.g0 * v0, x1 = l.b1 + c.g1 * v1;
        *(GAS f32x4*)(X + off) = x0; *(GAS f32x4*)(X + off + 16) = x1;
        st4bf(XG + off, x0 * c.m0); st4bf(XG + off + 16, x1 * c.m1);
        const float ss = sum_fq(dot4(x0) + dot4(x1));
        if (fq == 0) part[(row & 255) * 8 + c.slot] = ss; }
    __device__ __forceinline__ void post(const pg8::Unit& u, int wave, int lane) const {
        asm volatile("s_waitcnt lgkmcnt(0)" ::: "memory"); __builtin_amdgcn_s_barrier(); asm volatile("" ::: "memory");
        if (wave < 4) { const int r = wave * 64 + lane; const LAS float* p = part + r * 8;
            ((GAS float*)xstat)[(size_t)(u.pm * 256 + r) * 4 + u.pn] = ((p[0] + p[1]) + (p[2] + p[3])) + ((p[4] + p[5]) + (p[6] + p[7])); }
        asm volatile("s_waitcnt lgkmcnt(0)" ::: "memory"); __builtin_amdgcn_s_barrier(); asm volatile("" ::: "memory");
    }
};
struct F_Sqrelu {
    bf16_t* U; const float* xstat; const float* sv;
    struct Ctx { f32x4 s0, s1; }; struct Ld { f32x4 xs; };
    __device__ __forceinline__ Ctx prep(const pg8::Unit& u, int col) const { Ctx c; const float* sp = sv + (size_t)(u.pm >> 3) * FF + col; c.s0 = *(const GAS f32x4*)sp; c.s1 = *(const GAS f32x4*)(sp + 16); return c; }
    __device__ __forceinline__ Ld load(const Ctx&, const pg8::Unit&, int row, int) const { Ld l; l.xs = *(const GAS f32x4*)(xstat + (size_t)row * 4); return l; }
    __device__ __forceinline__ void finish(const Ctx& c, const pg8::Unit&, int row, int col, const Ld& l, f32x4 v0, f32x4 v1, int) const {
        const float rs = 1.0f / sqrtf(((l.xs[0] + l.xs[1]) + (l.xs[2] + l.xs[3])) * (1.0f / DM) + NORM_EPS);
        const f32x4 z = {0.f, 0.f, 0.f, 0.f};
        f32x4 a = __builtin_elementwise_max(v0 * rs + c.s0, z), b = __builtin_elementwise_max(v1 * rs + c.s1, z);
        bf16_t* o = U + (size_t)row * FF + col; st4bf(o, a * a); st4bf(o + 16, b * b); }
    __device__ __forceinline__ void post(const pg8::Unit&, int, int) const {}
};

struct EpiAll {
    int kind; unsigned char* ws; float* xo; const float* base; const float* gate; const float* gn; const float* scn; const float* sv; LAS float* part;
    template <class F> __device__ __forceinline__ void run(const F& f, const f32x4 (&acc)[2][2][4][2], const pg8::Unit& u, int wr, int wc) const { pg8::Epi<F> e{f}; e(acc, u, wr, wc, 0, 0); }
    __device__ __forceinline__ void operator()(const f32x4 (&acc)[2][2][4][2], const pg8::Unit& u, int wr, int wc, int, int) const {
        const float* cosT = (const float*)(ws + WS_COS); const float* sinT = (const float*)(ws + WS_SIN); float* xstat = (float*)(ws + WS_XSTAT); float* lstat = (float*)(ws + WS_LSTAT);
        if (kind == 0) run(F_ProjA{(bf16_t*)(ws + WS_P), xstat, sv, lstat, (bf16_t*)(ws + WS_KPE), cosT, sinT}, acc, u, wr, wc);
        else if (kind == 1) run(F_Qup{(bf16_t*)(ws + WS_QF), cosT, sinT, lstat}, acc, u, wr, wc);
        else if (kind == 2) run(F_Kvup{(bf16_t*)(ws + WS_KV), lstat}, acc, u, wr, wc);
        else if (kind == 3) run(F_Gate{(const bf16_t*)(ws + WS_P), (bf16_t*)(ws + WS_QF)}, acc, u, wr, wc);
        else if (kind == 4) run(F_Resid{base, xo, gate, gn, scn, (bf16_t*)(ws + WS_H), xstat, part}, acc, u, wr, wc);
        else run(F_Sqrelu{(bf16_t*)(ws + WS_P), xstat, sv}, acc, u, wr, wc);
    }
};

__device__ __forceinline__ int crow(int r, int hi) { return (r & 3) + 8 * (r >> 2) + 4 * hi; }
typedef short v4i16_t __attribute__((ext_vector_type(4)));
__device__ __forceinline__ s16x4 vtr(const LAS unsigned char* p) { return __builtin_bit_cast(s16x4, __builtin_amdgcn_ds_read_tr16_b64_v4i16((LAS v4i16_t*)p)); }

template <bool DIAG>
__device__ __forceinline__ void sb_half(const f32x16& y16, float& R, int kb, int tq, int hi, u32x4& pwa, u32x4& pwb) {
    float lf[16], ls[16];
#pragma unroll
    for (int r = 0; r < 16; ++r) {
        const float y = y16[r];
        const float sp = fmaxf(y, 0.f) + __builtin_amdgcn_logf(1.0f + __builtin_amdgcn_exp2f(-fabsf(y)));
        float l = -sp, s = y - sp;
        if (DIAG) { const bool valid = (kb + crow(r, hi)) < tq; l = valid ? l : 0.f; s = valid ? s : -INFINITY; }
        lf[r] = l; ls[r] = s;
    }
    float G[4], OS[4];
#pragma unroll
    for (int g = 0; g < 4; ++g) G[g] = (lf[4 * g] + lf[4 * g + 1]) + (lf[4 * g + 2] + lf[4 * g + 3]);
    OS[3] = G[3];
#pragma unroll
    for (int g = 2; g >= 0; --g) OS[g] = G[g] + OS[g + 1];
    const float T = sum_halves(OS[0]);
#pragma unroll
    for (int g = 0; g < 4; ++g) {
        const float ex = (g < 3) ? OS[g + 1] : 0.f;
        const float snd = hi ? OS[g] : ex;
        const float rcv = other_half(snd, hi);
        float w = R + ex + rcv;
        const float a3 = __builtin_amdgcn_exp2f(ls[4 * g + 3] + w); w += lf[4 * g + 3];
        const float a2 = __builtin_amdgcn_exp2f(ls[4 * g + 2] + w); w += lf[4 * g + 2];
        const float a1 = __builtin_amdgcn_exp2f(ls[4 * g + 1] + w); w += lf[4 * g + 1];
        const float a0 = __builtin_amdgcn_exp2f(ls[4 * g] + w);
        const unsigned lo = cvtpk(a0, a1), up = cvtpk(a2, a3);
        if (g == 0) { pwa[0] = lo; pwa[1] = up; } else if (g == 1) { pwa[2] = lo; pwa[3] = up; } else if (g == 2) { pwb[0] = lo; pwb[1] = up; } else { pwb[2] = lo; pwb[3] = up; }
    }
    R += T;
}
template <bool DIAG>
__device__ __forceinline__ float sm_weights(f32x16& p0, f32x16& p1, float& m, float& l, int kb, int tq, int hi, u32x4 (&pw)[4]) {
    if (DIAG) {
#pragma unroll
        for (int r = 0; r < 16; ++r) { const int key = kb + crow(r, hi); if (key > tq) p0[r] = -INFINITY; if (key + 32 > tq) p1[r] = -INFINITY; }
    }
    float mx = fmaxf(p0[0], p1[0]);
#pragma unroll
    for (int r = 1; r < 16; ++r) mx = fmaxf(mx, fmaxf(p0[r], p1[r]));
    mx = max_halves(mx);
    const float mn = fmaxf(m, mx), alpha = __builtin_amdgcn_exp2f(m - mn);
    m = mn;
    float sum = 0.f;
#pragma unroll
    for (int j = 0; j < 8; ++j) {
        const float a = __builtin_amdgcn_exp2f(p0[2 * j] - mn), b = __builtin_amdgcn_exp2f(p0[2 * j + 1] - mn), c = __builtin_amdgcn_exp2f(p1[2 * j] - mn), d = __builtin_amdgcn_exp2f(p1[2 * j + 1] - mn);
        sum += (a + b) + (c + d);
        pw[j >> 2][j & 3] = cvtpk(a, b); pw[2 + (j >> 2)][j & 3] = cvtpk(c, d);
    }
    l = l * alpha + sum;
    return alpha;
}

template <bool MLA>
__device__ __forceinline__ void attn_unit(LAS unsigned char* lds, int tid, int b, int qb,
                                          const bf16_t* Qp, int qpitch, int qoff, const bf16_t* Kp, int kpitch, int koff, const bf16_t* KPE,
                                          const bf16_t* Vp, int vpitch, int voff, bf16_t* Op, int opitch, int ooff) {
    asm volatile("" : "+v"(tid));
    constexpr int NKS = MLA ? 6 : 4;
    constexpr int BUFB = 20480, VOFF = 12288;
    const int lane = tid & 63, r32 = lane & 31, hi = lane >> 5;
    const int wid = __builtin_amdgcn_readfirstlane(tid >> 6);
    const size_t rowbase = (size_t)b * SEQ;
    const int q0 = qb * 256, tq = q0 + wid * 32 + r32, nt = 4 * qb + 4, wlast = 4 * qb + (wid >> 1);
    bf16x8 qr[NKS];
    { const bf16_t* qrow = Qp + (rowbase + tq) * qpitch + qoff + hi * 8;
#pragma unroll
      for (int ks = 0; ks < NKS; ++ks) qr[ks] = *(const GAS bf16x8*)(qrow + ks * 16); }
    const bf16_t* ksrc = Kp + (rowbase + lane) * kpitch + koff + wid * 8;
    const bf16_t* k2src = KPE + (rowbase + lane) * 32 + (wid & 3) * 8;
    const bf16_t* vsrc = Vp + (rowbase + 16 * (wid & 3) + (lane >> 2)) * vpitch + voff + (wid >> 2) * 32 + (lane & 3) * 8;
    const int kdst = wid * 1024 + lane * 16, k2dst = (8 + (wid & 3)) * 1024 + lane * 16, vdst = VOFF + wid * 1024 + lane * 16;
    const int kfrag = hi * 1024 + r32 * 16;
    const int vfrag = VOFF + ((lane >> 4) & 1) * 32 + (lane & 3) * 8 + (4 * hi + ((lane & 15) >> 2)) * 64;
    f32x16 o0, o1;
#pragma unroll
    for (int r = 0; r < 16; ++r) { o0[r] = 0.f; o1[r] = 0.f; }
    float R = 0.f, m_run = -INFINITY, l_run = 0.f;
    u32x4 kreg, vreg, k2reg;
#define TILE_OF(i) (MLA ? (i) : (nt - 1 - (i)))
#define LOADT(kt) do { kreg = *(const GAS u32x4*)(ksrc + (size_t)(kt) * 64 * kpitch); vreg = *(const GAS u32x4*)(vsrc + (size_t)(kt) * 64 * vpitch); \
        if (MLA) k2reg = *(const GAS u32x4*)(k2src + (size_t)(kt) * 64 * 32); } while (0)
#define WRITET(buf) do { *(LAS u32x4*)(lds + (buf) * BUFB + kdst) = kreg; *(LAS u32x4*)(lds + (buf) * BUFB + vdst) = vreg; \
        if (MLA && wid < 4) *(LAS u32x4*)(lds + (buf) * BUFB + k2dst) = k2reg; } while (0)
    constexpr float SB_EXIT = -48.0f;
    volatile LAS unsigned* cnt = (volatile LAS unsigned*)(lds + 2 * BUFB);
    if (!MLA && tid == 0) { cnt[0] = 0u; cnt[1] = 0u; cnt[2] = 0u; }
    bool wdone = false; int ci = 0;
    LOADT(TILE_OF(0)); WRITET(0); __syncthreads();
    for (int i = 0; i < nt; ++i) {
        const int kt = TILE_OF(i);
        const bool more = (i + 1 < nt);
        const int cn = (ci == 2) ? 0 : ci + 1;
        if (!MLA && tid == 0) cnt[cn] = 0u;
        if (more) LOADT(TILE_OF(i + 1));
        if (kt <= wlast && !wdone) {
            const LAS unsigned char* Kb = lds + (i & 1) * BUFB + kfrag;
            const int kb = kt * 64;
            u32x4 pw[4];
            if (MLA) {
                f32x16 p0, p1;
#pragma unroll
                for (int r = 0; r < 16; ++r) { p0[r] = 0.f; p1[r] = 0.f; }
#pragma unroll
                for (int ks = 0; ks < NKS; ++ks) {
                    const bf16x8 k0 = *(const LAS bf16x8*)(Kb + ks * 2048), k1 = *(const LAS bf16x8*)(Kb + ks * 2048 + 512);
                    p0 = MFMA32(k0, qr[ks], p0); p1 = MFMA32(k1, qr[ks], p1);
                }
                float alpha;
                if (kt == wlast) alpha = sm_weights<true>(p0, p1, m_run, l_run, kb, tq, hi, pw); else alpha = sm_weights<false>(p0, p1, m_run, l_run, kb, tq, hi, pw);
#pragma unroll
                for (int r = 0; r < 16; ++r) { o0[r] *= alpha; o1[r] *= alpha; }
            } else {
#pragma unroll
                for (int sub = 1; sub >= 0; --sub) {
                    f32x16 p;
#pragma unroll
                    for (int r = 0; r < 16; ++r) p[r] = 0.f;
#pragma unroll
                    for (int ks = 0; ks < NKS; ++ks) { const bf16x8 kf = *(const LAS bf16x8*)(Kb + ks * 2048 + sub * 512); p = MFMA32(kf, qr[ks], p); }
                    if (kt == wlast) sb_half<true>(p, R, kb + 32 * sub, tq, hi, pw[2 * sub], pw[2 * sub + 1]); else sb_half<false>(p, R, kb + 32 * sub, tq, hi, pw[2 * sub], pw[2 * sub + 1]);
                }
                wdone = (__builtin_amdgcn_ballot_w64(R > SB_EXIT) == 0ull);
            }
            const LAS unsigned char* Vb = lds + (i & 1) * BUFB + vfrag;
#pragma unroll
            for (int ks = 0; ks < 4; ++ks) {
                const bf16x8 pa = __builtin_bit_cast(bf16x8, pw[ks]);
                const s16x4 a0 = vtr(Vb + ks * 1024), a1 = vtr(Vb + ks * 1024 + 512), c0 = vtr(Vb + 4096 + ks * 1024), c1 = vtr(Vb + 4096 + ks * 1024 + 512);
                const bf16x8 v0 = {a0[0], a0[1], a0[2], a0[3], a1[0], a1[1], a1[2], a1[3]}, v1 = {c0[0], c0[1], c0[2], c0[3], c1[0], c1[1], c1[2], c1[3]};
                o0 = MFMA32(v0, pa, o0); o1 = MFMA32(v1, pa, o1);
            }
        }
        if (!MLA && wdone && lane == 0) __hip_atomic_fetch_add((LAS unsigned*)(lds + 2 * BUFB) + ci, 1u, __ATOMIC_RELAXED, __HIP_MEMORY_SCOPE_WORKGROUP);
        if (more) WRITET((i + 1) & 1);
        __syncthreads();
        if (!MLA) { if (cnt[ci] == (unsigned)NWAVES) break; ci = cn; }
    }
    if (!MLA) __syncthreads();
#undef TILE_OF
#undef LOADT
#undef WRITET
    if (MLA) { const float lt = sum_halves(l_run); const float inv = 1.0f / lt;
#pragma unroll
        for (int r = 0; r < 16; ++r) { o0[r] *= inv; o1[r] *= inv; } }
    bf16_t* orow = Op + (rowbase + tq) * opitch + ooff + 4 * hi;
#pragma unroll
    for (int g = 0; g < 4; ++g) {
        st4bf(orow + 8 * g, (f32x4){o0[4 * g], o0[4 * g + 1], o0[4 * g + 2], o0[4 * g + 3]});
        st4bf(orow + 32 + 8 * g, (f32x4){o1[4 * g], o1[4 * g + 1], o1[4 * g + 2], o1[4 * g + 3]});
    }
}


#ifndef DBG_NAIVE_SB
#define DBG_NAIVE_SB 0
#endif
#ifndef DBG_NAIVE_MLA
#define DBG_NAIVE_MLA 0
#endif
template <bool MLA>
__device__ __forceinline__ void naive_attn(int gtid, int nthreads, const bf16_t* Qp, int qpitch, int qstride_h, const bf16_t* Kp, int kpitch, int kstride_h, int koff0, const bf16_t* KPE,
                                           const bf16_t* Vp, int vpitch, int vstride_h, int voff0, bf16_t* Op) {
    constexpr int DK = MLA ? 96 : 64;
    for (int idx = gtid; idx < NB * 8 * SEQ; idx += nthreads) {
        const int t = idx % SEQ, h = (idx / SEQ) % 8, b = idx / (SEQ * 8);
        const size_t rowbase = (size_t)b * SEQ;
        float q[DK];
#pragma unroll
        for (int d = 0; d < DK; ++d) q[d] = bf2f(((const GAS bf16_t*)Qp)[(rowbase + t) * qpitch + h * qstride_h + d]);
        float o[64];
#pragma unroll
        for (int d = 0; d < 64; ++d) o[d] = 0.f;
        float R = 0.f, m = -INFINITY, l = 0.f;
        const int s_top = __builtin_amdgcn_readfirstlane(t & ~63) + 63;
        for (int s = s_top; s >= 0; --s) {
            const bool valid = MLA ? (s <= t) : (s < t);
            const GAS bf16_t* kr = (const GAS bf16_t*)Kp + (rowbase + s) * kpitch + koff0 + h * kstride_h;
            float y = 0.f;
#pragma unroll
            for (int d = 0; d < 64; ++d) y += q[d] * bf2f(kr[d]);
            if (MLA) {
                const GAS bf16_t* kp2 = (const GAS bf16_t*)KPE + (rowbase + s) * 32;
#pragma unroll
                for (int d = 0; d < 32; ++d) y += q[64 + d] * bf2f(kp2[d]);
            }
            float w = 0.f;
            if (MLA) {
                if (valid) { const float mn = fmaxf(m, y), al = exp2f(m - mn); w = exp2f(y - mn); l = l * al + w; m = mn;
#pragma unroll
                    for (int d = 0; d < 64; ++d) o[d] *= al; }
            } else {
                if (valid) { const float sp = fmaxf(y, 0.f) + log2f(1.0f + exp2f(-fabsf(y))); w = exp2f((y - sp) + R); R -= sp; }
            }
            const GAS bf16_t* vr = (const GAS bf16_t*)Vp + (rowbase + s) * vpitch + voff0 + h * vstride_h;
#pragma unroll
            for (int d = 0; d < 64; ++d) o[d] += w * bf2f(vr[d]);
        }
        const float inv = MLA ? 1.0f / l : 1.0f;
#pragma unroll
        for (int d = 0; d < 64; d += 2) { const unsigned pk = cvtpk(o[d] * inv, o[d + 1] * inv); *(GAS unsigned*)(Op + (rowbase + t) * 512 + h * 64 + d) = pk; }
    }
}

typedef GAS unsigned gu32;
#define RLX_AGENT __ATOMIC_RELAXED, __HIP_MEMORY_SCOPE_AGENT
#define XB_TMO      128
#define XB_XCNT(j)  (256  + 64 * (j))
#define XB_XSUB(j)  (1280 + 64 * (j))
#define XB_XGEN(j)  (2304 + 64 * (j))
#define XB_TOP      3328
#define XB_TOPGEN   3392
#define XCD_BAR_WORDS 3456
#define XB_SPIN_CAP (1u << 18)
constexpr int CW_BAR = 4096;
__device__ __forceinline__ unsigned xb_ld(unsigned* p)              { return __hip_atomic_load(p, __ATOMIC_RELAXED, __HIP_MEMORY_SCOPE_AGENT); }
__device__ __forceinline__ unsigned xb_add(unsigned* p, unsigned v) { return __hip_atomic_fetch_add(p, v, __ATOMIC_RELAXED, __HIP_MEMORY_SCOPE_AGENT); }
__device__ __forceinline__ unsigned xb_xcc_id() { return (unsigned)__builtin_amdgcn_s_getreg((3 << 11) | 20) & 0xFu; }
#define XB_SPIN(cond, bar) do { unsigned _sp = 0; while (cond) { __builtin_amdgcn_s_sleep(1); \
    if ((++_sp & 255u) == 0u) { if (xb_ld(&(bar)[XB_TMO])) break; if (_sp > XB_SPIN_CAP) { atomicAdd(&(bar)[XB_TMO], 1u); break; } } } } while (0)
struct XcdBarrier { unsigned* bar; unsigned x; volatile LAS unsigned* st; };
__device__ __forceinline__ XcdBarrier xcd_barrier_post(unsigned* bar, volatile LAS unsigned* st) {
    XcdBarrier b; b.bar = bar; b.x = xb_xcc_id(); b.st = st;
    if (threadIdx.x == 0) (void)xb_add(&bar[XB_XCNT(b.x)], 1u);
    return b;
}
__device__ __forceinline__ void xcd_barrier_complete(unsigned* bar, unsigned x, unsigned& nloc, unsigned& nx) {
    const unsigned G = gridDim.x * gridDim.y * gridDim.z;
    unsigned sum, cnt, mine, sp = 0u;
    for (;;) {
        sum = 0u; cnt = 0u; mine = 0u;
#pragma unroll 1
        for (unsigned j = 0; j < 16; ++j) { const unsigned c = xb_ld(&bar[XB_XCNT(j)]); sum += c; cnt += (c > 0u) ? 1u : 0u; mine = (j == x) ? c : mine; }
        if (sum == G) break;
        __builtin_amdgcn_s_sleep(1);
        if ((++sp & 255u) == 0u) { if (xb_ld(&bar[XB_TMO])) break; if (sp > XB_SPIN_CAP) { atomicAdd(&bar[XB_TMO], 1u); break; } }
    }
    nloc = mine > 0u ? mine : 1u; nx = cnt > 0u ? cnt : 1u;
}
__device__ __forceinline__ void xcd_barrier(const XcdBarrier& b) {
    asm volatile("s_waitcnt vmcnt(0)" ::: "memory");
    __syncthreads();
    if (threadIdx.x == 0) {
        unsigned* bar = b.bar;
        __builtin_amdgcn_s_waitcnt(0);
        unsigned nloc = b.st[0], nx = b.st[1];
        if (nloc == 0u) { xcd_barrier_complete(bar, b.x, nloc, nx); b.st[0] = nloc; b.st[1] = nx; }
        const unsigned old = xb_add(&bar[XB_XSUB(b.x)], 1u);
        const unsigned gen = old / nloc;
        if (old + 1u == (gen + 1u) * nloc) {
            __builtin_amdgcn_fence(__ATOMIC_RELEASE, "agent");
            asm volatile("s_waitcnt vmcnt(0)" ::: "memory");
            const unsigned og = xb_add(&bar[XB_TOP], 1u);
            const unsigned tg = og / nx;
            if (og + 1u == (tg + 1u) * nx) xb_add(&bar[XB_TOPGEN], 1u);
            else XB_SPIN(xb_ld(&bar[XB_TOPGEN]) == tg, bar);
            __builtin_amdgcn_fence(__ATOMIC_ACQUIRE, "agent");
            xb_add(&bar[XB_XGEN(b.x)], 1u);
            asm volatile("s_waitcnt vmcnt(0)" ::: "memory");
        } else {
            XB_SPIN(xb_ld(&bar[XB_XGEN(b.x)]) == gen, bar);
            __builtin_amdgcn_fence(__ATOMIC_ACQUIRE, "agent");
            asm volatile("s_waitcnt vmcnt(0)" ::: "memory");
        }
    }
    __syncthreads();
}

struct Args { const void* in[18]; float* out; unsigned char* ws; int ph_lo, ph_hi; };
struct Frame {
    LAS unsigned char* lds;
    int tid, lane, wave, vcu, G;
};
typedef const void* cvp_t;
__device__ __forceinline__ const void* arg_in(int i) { const __attribute__((address_space(4))) cvp_t* p = (const __attribute__((address_space(4))) cvp_t*)__builtin_amdgcn_kernarg_segment_ptr(); asm volatile("" : "+s"(p)); return p[i]; }

__device__ __forceinline__ void transpose_item(const float* W, int K, int N, bf16_t* WT, int thresh, int add, const float* gain, LAS float* scr, int item, int lane) {
    const int nblk = N / 32, kb = item / nblk, nb = item % nblk, k0 = 64 * kb, n0 = 32 * nb;
#pragma unroll 8
    for (int i = 0; i < 32; ++i) { const int kk = 2 * i + (lane >> 5); scr[kk * 33 + (lane & 31)] = ((const GAS float*)W)[(size_t)(k0 + kk) * N + n0 + (lane & 31)]; }
    LDS_WAIT(); asm volatile("" ::: "memory");
    const int c = lane & 7;
    float gv[8];
#pragma unroll
    for (int e = 0; e < 8; ++e) gv[e] = gain ? ((const GAS float*)gain)[k0 + 8 * c + e] : 1.0f;
    const int radd = (n0 >= thresh) ? add : 0;
#pragma unroll
    for (int j = 0; j < 4; ++j) { const int n = (lane >> 3) + 8 * j; const LAS float* s = scr + (8 * c) * 33 + n;
        u32x4 o; o.x = cvtpk(s[0 * 33] * gv[0], s[1 * 33] * gv[1]); o.y = cvtpk(s[2 * 33] * gv[2], s[3 * 33] * gv[3]); o.z = cvtpk(s[4 * 33] * gv[4], s[5 * 33] * gv[5]); o.w = cvtpk(s[6 * 33] * gv[6], s[7 * 33] * gv[7]);
        *(GAS u32x4*)(WT + (size_t)(radd + n0 + n) * K + k0 + 8 * c) = o; }
    LDS_WAIT(); asm volatile("" ::: "memory");
}

__device__ __forceinline__ void gemv8_item(const Frame& F, const LAS float* vec, LAS float* red, const float* W, int ldw, int n0, int nvalid, const float* bias, float* out, size_t ostride, int split, int add) {
    const int n = F.tid & 63, kc = F.tid >> 6; const bool ok = (n0 + n) < nvalid;
    const GAS float* w = (const GAS float*)W + (size_t)(kc * 128) * ldw + n0 + n;
    float acc[8];
#pragma unroll
    for (int b = 0; b < 8; ++b) acc[b] = 0.f;
#pragma unroll 4
    for (int k = 0; k < 128; ++k) { const float wv = ok ? w[(size_t)k * ldw] : 0.f;
#pragma unroll
        for (int b = 0; b < 8; ++b) acc[b] += wv * vec[b * DM + kc * 128 + k]; }
#pragma unroll
    for (int b = 0; b < 8; ++b) red[(kc * 8 + b) * 64 + n] = acc[b];
    __syncthreads();
    { const int b = F.tid >> 6; float s = (bias && ok) ? ((const GAS float*)bias)[n0 + n] : 0.f;
#pragma unroll
      for (int k2 = 0; k2 < 8; ++k2) s += red[(k2 * 8 + b) * 64 + n];
      if (ok) ((GAS float*)out)[(size_t)b * ostride + (n0 + n) + ((n0 + n) >= split ? add : 0)] = s; }
    __syncthreads();
}
__device__ __forceinline__ void phase_p0a(const Frame& F, unsigned char* ws) {
    const int gt = blockIdx.x * 512 + F.tid, NT = F.G * 512;
    { const int* pos = (const int*)arg_in(2); float* cosT = (float*)(ws + WS_COS); float* sinT = (float*)(ws + WS_SIN);
      for (int idx = gt; idx < MTOK * 16; idx += NT) { const int t = idx >> 4, i = idx & 15;
          const float inv = 1.0f / __builtin_amdgcn_exp2f((float)(2 * i) * (13.287712379549449f / 32.0f));
          const float ang = (float)((const GAS int*)pos)[t] * inv;
          double rev = (double)ang * 0.15915494309189535; rev -= __builtin_rint(rev);
          const float fr = (float)rev;
          ((GAS float*)cosT)[idx] = __builtin_amdgcn_cosf(fr); ((GAS float*)sinT)[idx] = __builtin_amdgcn_sinf(fr); } }
    { const float* c = (const float*)arg_in(1); LAS float* cact = (LAS float*)F.lds; LAS float* red = (LAS float*)(F.lds + 32768);
      for (int i = F.tid; i < NB * DM; i += 512) { const float v = ((const GAS float*)c)[i]; cact[i] = v / (1.0f + __expf(-v)); }
      __syncthreads();
      for (int item = blockIdx.x; item < DEPTH * 96; item += F.G) { const int l = item / 96, n0 = (item % 96) * 64;
          gemv8_item(F, cact, red, (const float*)arg_in(3) + (size_t)l * DM * (6 * DM), 6 * DM, n0, 6 * DM, (const float*)arg_in(4) + l * (6 * DM), (float*)(ws + WS_MODS) + (size_t)l * NB * (6 * DM), 6 * DM, 1 << 30, 0); } }
}
__device__ __forceinline__ void phase_p0b(const Frame& F, unsigned char* ws) {
    const int gt = blockIdx.x * 512 + F.tid, NT = F.G * 512;
    const float* mods = (const float*)(ws + WS_MODS);
    { LAS float* vec = (LAS float*)F.lds; LAS float* red = (LAS float*)(F.lds + 32768);
      constexpr int I1 = (IN_NAT + 63) / 64, I2 = FF / 64;
      for (int item = blockIdx.x; item < DEPTH * (I1 + I2); item += F.G) {
          const int l = item / (I1 + I2), r = item % (I1 + I2); const bool up = r >= I1; const int part = up ? 3 : 0;
          for (int i = F.tid; i < NB * DM; i += 512) vec[i] = ((const GAS float*)mods)[((size_t)l * NB + (i >> 10)) * (6 * DM) + part * DM + (i & 1023)];
          __syncthreads();
          if (!up) { const int n0 = r * 64; gemv8_item(F, vec, red, (const float*)arg_in(6) + (size_t)l * DM * IN_NAT, IN_NAT, n0, IN_NAT, nullptr, (float*)(ws + WS_SV1) + (size_t)l * NB * NPJ, NPJ, IN_SPLIT, NPJ - IN_NAT); }
          else { const int n0 = (r - I1) * 64; gemv8_item(F, vec, red, (const float*)arg_in(15) + (size_t)l * DM * FF, FF, n0, FF, nullptr, (float*)(ws + WS_SV2) + (size_t)l * NB * FF, FF, 1 << 30, 0); }
      }
      for (int idx = gt; idx < DEPTH * NB * (C_GSB - IN_SPLIT); idx += NT) { const int c = idx % (C_GSB - IN_SPLIT), lb = idx / (C_GSB - IN_SPLIT); ((GAS float*)(ws + WS_SV1))[(size_t)lb * NPJ + IN_SPLIT + c] = 0.f; }
    }
    { LAS float* scr = (LAS float*)(F.lds + F.wave * 16384);
      const int gw = F.vcu * NWAVES + F.wave, NGW = F.G * NWAVES;
      constexpr int I_IN = (DM / 64) * (IN_NAT / 32), I_QUP = (QRANK / 64) * (QFULL / 32), I_KVUP = (KVRANK / 64) * (KVW / 32), I_SB = (512 / 64) * (DM / 32), I_MIX = (DM / 64) * (DM / 32),
                    I_UP = (DM / 64) * (FF / 32), I_DOWN = (FF / 64) * (DM / 32), I_LAYER = I_IN + I_QUP + I_KVUP + 2 * I_SB + I_MIX + I_UP + I_DOWN;
      for (int it = gw; it < DEPTH * I_LAYER; it += NGW) {
          const int l = it / I_LAYER; int r = it % I_LAYER;
          unsigned char* wl = ws + WS_W + (size_t)l * LAYER_W;
          if (r < I_IN) { transpose_item((const float*)arg_in(6) + (size_t)l * DM * IN_NAT, DM, IN_NAT, (bf16_t*)(wl + OW_IN), IN_SPLIT, NPJ - IN_NAT, nullptr, scr, r, F.lane); continue; } r -= I_IN;
          if (r < I_QUP) { transpose_item((const float*)arg_in(8) + (size_t)l * QRANK * QFULL, QRANK, QFULL, (bf16_t*)(wl + OW_QUP), 1 << 30, 0, (const float*)arg_in(7) + l * QRANK, scr, r, F.lane); continue; } r -= I_QUP;
          if (r < I_KVUP) { transpose_item((const float*)arg_in(10) + (size_t)l * KVRANK * KVW, KVRANK, KVW, (bf16_t*)(wl + OW_KVUP), 1 << 30, 0, (const float*)arg_in(9) + l * KVRANK, scr, r, F.lane); continue; } r -= I_KVUP;
          if (r < I_SB) { transpose_item((const float*)arg_in(11) + (size_t)l * 512 * DM, 512, DM, (bf16_t*)(wl + OW_SB), 1 << 30, 0, nullptr, scr, r, F.lane); continue; } r -= I_SB;
          if (r < I_SB) { transpose_item((const float*)arg_in(12) + (size_t)l * 512 * DM, 512, DM, (bf16_t*)(wl + OW_MLA), 1 << 30, 0, nullptr, scr, r, F.lane); continue; } r -= I_SB;
          if (r < I_MIX) { transpose_item((const float*)arg_in(13) + (size_t)l * DM * DM, DM, DM, (bf16_t*)(wl + OW_MIX), 1 << 30, 0, nullptr, scr, r, F.lane); continue; } r -= I_MIX;
          if (r < I_UP) { transpose_item((const float*)arg_in(15) + (size_t)l * DM * FF, DM, FF, (bf16_t*)(wl + OW_UP), 1 << 30, 0, nullptr, scr, r, F.lane); continue; } r -= I_UP;
          transpose_item((const float*)arg_in(16) + (size_t)l * FF * DM, FF, DM, (bf16_t*)(wl + OW_DOWN), 1 << 30, 0, nullptr, scr, r, F.lane);
      }
      constexpr int ZV = (C_GSB - IN_SPLIT) * DM * 2 / 16;
      unsigned zu = 0u; asm volatile("" : "+v"(zu));
      for (int idx = gt; idx < DEPTH * ZV; idx += NT) { const int l = idx / ZV, r = idx % ZV;
          *(GAS u32x4*)(ws + WS_W + (size_t)l * LAYER_W + OW_IN + (size_t)IN_SPLIT * DM * 2 + (size_t)r * 16) = (u32x4){zu, zu, zu, zu}; }
      const float* x = (const float*)arg_in(0); const float* g = (const float*)arg_in(5);
      for (int m = gw; m < MTOK; m += NGW) {
          const GAS f32x4* xr = (const GAS f32x4*)(x + (size_t)m * DM) + F.lane;
          const float* sc = mods + (size_t)(m >> 11) * (6 * DM) + DM;
          float ss = 0.f;
#pragma unroll
          for (int j = 0; j < 4; ++j) { const int c = 4 * F.lane + 256 * j; const f32x4 v = xr[64 * j]; ss += dot4(v);
              st4bf((bf16_t*)(ws + WS_H) + (size_t)m * DM + c, v * (*(const GAS f32x4*)(g + c) * (1.0f + *(const GAS f32x4*)(sc + c)))); }
          ss = wave_sum(ss);
          if (F.lane == 0) *(GAS f32x4*)(ws + WS_XSTAT + (size_t)m * 16) = (f32x4){ss, 0.f, 0.f, 0.f};
      }
    }
}

__device__ __forceinline__ void phase_final(const Frame& F, float* X, const float* g) {
    const int gw = F.vcu * NWAVES + F.wave, NGW = F.G * NWAVES;
    for (int m = gw; m < MTOK; m += NGW) {
        GAS f32x4* xr = (GAS f32x4*)(X + (size_t)m * DM) + F.lane;
        f32x4 v[4]; float ss = 0.f;
#pragma unroll
        for (int j = 0; j < 4; ++j) { v[j] = xr[64 * j]; ss += (v[j][0] * v[j][0] + v[j][1] * v[j][1]) + (v[j][2] * v[j][2] + v[j][3] * v[j][3]); }
        const float rs = 1.0f / sqrtf(wave_sum(ss) * (1.0f / DM) + NORM_EPS);
#pragma unroll
        for (int j = 0; j < 4; ++j) xr[64 * j] = (v[j] * rs) * *(const GAS f32x4*)(g + 4 * F.lane + 256 * j);
    }
}

constexpr int STEPS = 8;
constexpr int N_PHASES = 3 + STEPS * DEPTH;

__global__ void __launch_bounds__(NWAVES * 64, 2) mk_fwd(Args a) {
    extern __shared__ __attribute__((aligned(16))) unsigned char lds_raw[];
    Frame F;
    F.lds = (LAS unsigned char*)lds_raw;
    F.tid = threadIdx.x; F.lane = F.tid & 63; F.wave = __builtin_amdgcn_readfirstlane(F.tid >> 6);
    F.G = gridDim.x; { const int bx = blockIdx.x; F.vcu = (F.G % 8 == 0) ? (bx % 8) * (F.G / 8) + bx / 8 : bx; }
    unsigned char* ws0 = a.ws;
    volatile LAS unsigned* MISC = (volatile LAS unsigned*)(F.lds + MISC_OFF);
    for (int u = F.tid; u < (LDS_BYTES - LDSCTL_OFF) / 4; u += NWAVES * 64) ((LAS unsigned*)(F.lds + LDSCTL_OFF))[u] = 0u;
    __syncthreads();
    const int lo = a.ph_lo, hi = a.ph_hi;
    XcdBarrier bar; bar.bar = (unsigned*)(ws0 + WS_CTL) + CW_BAR; bar.x = 0; bar.st = nullptr;
    if (hi - lo > 1) bar = xcd_barrier_post((unsigned*)(ws0 + WS_CTL) + CW_BAR, MISC + 8);

#define cosT ((const float*)(ws + WS_COS))
#define sinT ((const float*)(ws + WS_SIN))
#define P    ((bf16_t*)(ws + WS_P))
#define U    ((bf16_t*)(ws + WS_P))
#define QF   ((bf16_t*)(ws + WS_QF))
#define KV   ((bf16_t*)(ws + WS_KV))
#define MG   ((bf16_t*)(ws + WS_QF))
#define KPE  ((bf16_t*)(ws + WS_KPE))
#define H    ((bf16_t*)(ws + WS_H))
#define OSB  ((bf16_t*)(ws + WS_H))
#define OMLA ((bf16_t*)(ws + WS_H) + (size_t)MTOK * 512)
#define X    (a.out)
#define wl (ws + WS_W + (size_t)l * LAYER_W)
#define mods_l ((const float*)(ws + WS_MODS) + (size_t)l * NB * (6 * DM))
#define xin ((l == 0) ? (const float*)arg_in(0) : (const float*)X)

#define REFRESH() { unsigned z_ = 0u; asm volatile("" : "+v"(z_)); const int l_ = (int)__builtin_amdgcn_mbcnt_hi(~0u, __builtin_amdgcn_mbcnt_lo(~0u, z_)); F.lane = l_; F.tid = F.wave * 64 + l_; }
#define FRESH() int bx_; unsigned char* ws; { unsigned z_ = 0u; asm volatile("" : "+v"(z_)); const int l_ = (int)__builtin_amdgcn_mbcnt_hi(~0u, __builtin_amdgcn_mbcnt_lo(~0u, z_)); F.lane = l_; F.tid = F.wave * 64 + l_; \
        bx_ = blockIdx.x; asm volatile("" : "+s"(bx_)); ws = ws0; asm volatile("" : "+s"(ws)); }
#ifndef DUP_MASK
#define DUP_MASK 0
#endif
    for (int ph = lo; ph < hi; ++ph) {
        const int l = (ph - 2) / STEPS, t = (ph == 0) ? -1 : (ph == 1) ? -3 : (ph == N_PHASES - 1) ? -2 : (ph - 2) % STEPS;
        bool skip_bar = false;
        for (int rep = (DUP_MASK && t >= 0 && ((DUP_MASK >> t) & 1)) ? 0 : 1; rep < 2; ++rep) {
        if (DUP_MASK && rep == 1 && t >= 0 && ((DUP_MASK >> t) & 1)) xcd_barrier(bar);
        if (t == -1) {
            FRESH(); (void)bx_;
            phase_p0a(F, ws);
        } else if (t == -3) {
            FRESH(); (void)bx_;
            phase_p0b(F, ws);
        } else if (t == -2) {
            FRESH(); (void)bx_; (void)ws;
            phase_final(F, X, (const float*)arg_in(17));
        } else if (t == 3) {
            FRESH(); (void)bx_;
#if DBG_NAIVE_SB
            naive_attn<false>(blockIdx.x * 512 + F.tid, F.G * 512, P, NPJ, 64, P, NPJ, 64, C_KSB, KPE, P, NPJ, 64, C_VSB, OSB);
#endif
#if DBG_NAIVE_MLA
            naive_attn<true>(blockIdx.x * 512 + F.tid, F.G * 512, QF, QFULL, 96, KV, KVW, 128, 0, KPE, KV, KVW, 128, 64, OMLA);
#endif
            for (int pi = F.vcu; pi < 256; pi += F.G) {
                const int bh = pi >> 2, s = pi & 3, b = bh >> 3, h = bh & 7;
#if !DBG_NAIVE_SB
#pragma unroll 1
                for (int k = 0; k < 2; ++k) { const int qb = k ? 7 - s : s;
                    attn_unit<false>(F.lds, F.tid, b, qb, P, NPJ, C_QSB + h * 64, P, NPJ, C_KSB + h * 64, KPE, P, NPJ, C_VSB + h * 64, OSB, 512, h * 64); }
#endif
#if !DBG_NAIVE_MLA
#pragma unroll 1
                for (int k = 0; k < 2; ++k) { const int qb = k ? 7 - s : s;
                    attn_unit<true>(F.lds, F.tid, b, qb, QF, QFULL, h * 96, KV, KVW, h * 128, KPE, KV, KVW, h * 128 + 64, OMLA, 512, h * 64); }
#endif
                (void)b; (void)h; (void)s;
            }
        } else {
            FRESH();
            pg8::Gemm g; pg8::Order S; EpiAll E; int N = DM, crot = 0;
            g.A2 = nullptr; g.Bt2 = nullptr; S.pair = 0;
            E.ws = ws; E.xo = X; E.base = nullptr; E.gate = nullptr; E.gn = nullptr; E.scn = nullptr; E.sv = nullptr; E.part = (LAS float*)(F.lds + LDSCTL_OFF + 1024);
            if (t == 0) {
                g.A = H; g.Bt = (const bf16_t*)(wl + OW_IN); g.lda = DM; g.ldb = DM; g.K = DM; N = NPJ; E.kind = 0; E.sv = (const float*)(ws + WS_SV1) + (size_t)l * NB * NPJ;
            } else if (t == 1) {
                g.A = P + C_QLAT; g.Bt = (const bf16_t*)(wl + OW_QUP); g.lda = NPJ; g.ldb = QRANK; g.K = QRANK; N = QFULL; E.kind = 1; skip_bar = true;
            } else if (t == 2) {
                g.A = P + C_KVLAT; g.Bt = (const bf16_t*)(wl + OW_KVUP); g.lda = NPJ; g.ldb = KVRANK; g.K = KVRANK; N = KVW; E.kind = 2; crot = 192;
            } else if (t == 4) {
                g.A = OSB; g.Bt = (const bf16_t*)(wl + OW_SB); g.A2 = OMLA; g.Bt2 = (const bf16_t*)(wl + OW_MLA); g.lda = 512; g.ldb = 512; g.K = 512; S.pair = 1; E.kind = 3;
            } else if (t == 6) {
                g.A = H; g.Bt = (const bf16_t*)(wl + OW_UP); g.lda = DM; g.ldb = DM; g.K = DM; N = FF; E.kind = 5; E.sv = (const float*)(ws + WS_SV2) + (size_t)l * NB * FF;
            } else {
                const bool isF = (t == 7);
                g.A = isF ? U : MG; g.Bt = (const bf16_t*)(wl + (isF ? OW_DOWN : OW_MIX)); g.lda = isF ? FF : DM; g.ldb = g.lda; g.K = g.lda;
                E.kind = 4; E.base = isF ? (const float*)X : xin; E.gate = mods_l + (isF ? 5 : 2) * DM;
                const int ln = isF ? ((l + 1 < DEPTH) ? l + 1 : l) : l;
                E.gn = (const float*)arg_in(isF ? 5 : 14) + ln * DM; E.scn = (const float*)(ws + WS_MODS) + (size_t)ln * NB * (6 * DM) + (isF ? 1 : 4) * DM;
            }
            S.s.init(MTOK, N, F.G, (int)(((unsigned)bx_ + (unsigned)crot) % (unsigned)F.G));
            pg8::gemm_phase<EpiAll, pg8::Order, true>(F.lds, F.tid, g, S, E);
        }
        }
        if (ph + 1 < hi && !skip_bar) xcd_barrier(bar);
    }
}

extern "C" void kernel_launch(void* const* d_in, const int* in_sizes, int n_in, void* d_out, int out_size, void* d_ws, size_t ws_size, hipStream_t stream) {
    static int grid = 0;
    if (grid == 0) {
        if (n_in != 18 || in_sizes[0] != MTOK * DM || out_size != MTOK * DM || ws_size < WS_END) {
            fprintf(stderr, "kernel_launch: unexpected shapes (n_in %d, in0 %d, out %d, ws %zu); nothing launched\n", n_in, n_in > 0 ? in_sizes[0] : -1, out_size, ws_size); grid = -1; return; }
        int dev = 0, cus = 0, per_cu = 0;
        if (hipGetDevice(&dev) != hipSuccess || hipDeviceGetAttribute(&cus, hipDeviceAttributeMultiprocessorCount, dev) != hipSuccess) { grid = -1; return; }
        if (hipFuncSetAttribute((const void*)mk_fwd, hipFuncAttributeMaxDynamicSharedMemorySize, LDS_BYTES) != hipSuccess) { fprintf(stderr, "kernel_launch: hipFuncSetAttribute failed\n"); grid = -1; return; }
        if (hipOccupancyMaxActiveBlocksPerMultiprocessor(&per_cu, (const void*)mk_fwd, NWAVES * 64, LDS_BYTES) != hipSuccess || per_cu < 1) {
            fprintf(stderr, "kernel_launch: occupancy query reports %d workgroups per CU; nothing launched\n", per_cu); (void)hipGetLastError(); grid = -1; return; }
        grid = cus;
    }
    if (grid < 0) return;
    (void)hipMemsetAsync((char*)d_ws + WS_CTL, 0, CTL_ZERO_BYTES, stream);
    Args a{};
    for (int i = 0; i < 18; ++i) a.in[i] = d_in[i];
    a.out = (float*)d_out; a.ws = (unsigned char*)d_ws;
#if MK_N_LAUNCHES == 1
    a.ph_lo = 0; a.ph_hi = N_PHASES;
    void* kargs[] = {&a};
    hipError_t e = hipLaunchCooperativeKernel((const void*)mk_fwd, dim3(grid), dim3(NWAVES * 64), kargs, LDS_BYTES, stream);
    if (e != hipSuccess) fprintf(stderr, "kernel_launch: cooperative launch failed: %s (grid %d)\n", hipGetErrorString(e), grid);
#else
    for (int ph = 0; ph < N_PHASES; ++ph) {
        a.ph_lo = ph; a.ph_hi = ph + 1;
        hipLaunchKernelGGL(mk_fwd, dim3(grid), dim3(NWAVES * 64), LDS_BYTES, stream, a);
    }
#endif
}
```

```cpp
#include <hip/hip_runtime.h>
#include <cstdio>
#include <cstdint>

#ifndef MK_N_LAUNCHES
#define MK_N_LAUNCHES 1
#endif

#define LAS __attribute__((address_space(3)))
#define GAS __attribute__((address_space(1)))
typedef unsigned short bf16_t;
typedef short bf16x8 __attribute__((ext_vector_type(8)));
typedef short s16x4 __attribute__((ext_vector_type(4)));
typedef float f32x2 __attribute__((ext_vector_type(2)));
typedef float f32x4 __attribute__((ext_vector_type(4)));
typedef float f32x16 __attribute__((ext_vector_type(16)));
typedef unsigned u32x2 __attribute__((ext_vector_type(2)));
typedef unsigned u32x4 __attribute__((ext_vector_type(4)));
typedef __bf16 bf16x2_t __attribute__((ext_vector_type(2)));

constexpr int DM = 1024, NB = 8, SEQ = 2048, MTOK = NB * SEQ, DEPTH = 4, FF = 4096;
constexpr int NPJ = 4352;
constexpr int C_QSB = 0, C_KSB = 512, C_VSB = 1024, C_QLAT = 1536, C_KVLAT = 1920, C_KROPE = 2176, C_GSB = 2304, C_GMLA = 3328;
constexpr int IN_NAT = 4256, IN_SPLIT = 2208;
constexpr int QRANK = 384, KVRANK = 256, QFULL = 768, KVW = 1024;
constexpr float NORM_EPS = 1e-6f;
constexpr float LOG2E = 1.4426950408889634f;
constexpr float C2SB = 0.125f * LOG2E;
constexpr float C2MLA = 0.10206207261596577f * LOG2E;

constexpr size_t MiB = 1u << 20;
constexpr size_t WS_CTL = 0, CTL_ZERO_BYTES = 1 * MiB;
constexpr size_t WS_COS = 1 * MiB, WS_SIN = 2 * MiB;
constexpr size_t WS_MODS = 3 * MiB;
constexpr size_t WS_XSTAT = 3 * MiB + 786432;
constexpr size_t WS_W = 4 * MiB;
constexpr size_t OW_IN = 0, OW_QUP = OW_IN + (size_t)NPJ * DM * 2, OW_KVUP = OW_QUP + (size_t)QFULL * QRANK * 2, OW_SB = OW_KVUP + (size_t)KVW * KVRANK * 2,
                 OW_MLA = OW_SB + (size_t)DM * 512 * 2, OW_MIX = OW_MLA + (size_t)DM * 512 * 2, OW_UP = OW_MIX + (size_t)DM * DM * 2, OW_DOWN = OW_UP + (size_t)FF * DM * 2,
                 LAYER_W = OW_DOWN + (size_t)DM * FF * 2;
constexpr size_t WS_P = 123 * MiB;
constexpr size_t WS_QF = 259 * MiB;
constexpr size_t WS_KV = 283 * MiB;
constexpr size_t WS_LSTAT = 315 * MiB;
constexpr size_t WS_SV1 = 317 * MiB;
constexpr size_t WS_SV2 = 318 * MiB;
constexpr size_t WS_KPE = 335 * MiB;
constexpr size_t WS_H = 336 * MiB;
constexpr size_t WS_END = 368 * MiB;
static_assert(WS_W + DEPTH * LAYER_W <= WS_P, "weights fit");

constexpr int RING_BYTES = 131072;
constexpr int LDSCTL_OFF = RING_BYTES, MISC_OFF = LDSCTL_OFF + 320;
constexpr int LDS_BYTES = 147456;
constexpr int NWAVES = 8;

#ifndef USE_F16
#define USE_F16 1
#endif
typedef _Float16 half2_t __attribute__((ext_vector_type(2)));
typedef _Float16 half8_t __attribute__((ext_vector_type(8)));
#if USE_F16
__device__ __forceinline__ unsigned cvtpk(float lo, float hi) { f32x2 v = {lo, hi}; half2_t b = __builtin_convertvector(v, half2_t); return __builtin_bit_cast(unsigned, b); }
__device__ __forceinline__ float bf2f(unsigned short h) { return (float)__builtin_bit_cast(_Float16, h); }
__device__ __forceinline__ float up_lo(unsigned w) { return (float)__builtin_bit_cast(half2_t, w)[0]; }
__device__ __forceinline__ float up_hi(unsigned w) { return (float)__builtin_bit_cast(half2_t, w)[1]; }
#define MFMA16(a, b, c) __builtin_amdgcn_mfma_f32_16x16x32_f16(__builtin_bit_cast(half8_t, a), __builtin_bit_cast(half8_t, b), c, 0, 0, 0)
#define MFMA32(a, b, c) __builtin_amdgcn_mfma_f32_32x32x16_f16(__builtin_bit_cast(half8_t, a), __builtin_bit_cast(half8_t, b), c, 0, 0, 0)
#else
__device__ __forceinline__ unsigned cvtpk(float lo, float hi) { f32x2 v = {lo, hi}; bf16x2_t b = __builtin_convertvector(v, bf16x2_t); return __builtin_bit_cast(unsigned, b); }
__device__ __forceinline__ float bf2f(unsigned short h) { return __builtin_bit_cast(float, (unsigned)h << 16); }
__device__ __forceinline__ float up_lo(unsigned w) { return __builtin_bit_cast(float, w << 16); }
__device__ __forceinline__ float up_hi(unsigned w) { return __builtin_bit_cast(float, w & 0xffff0000u); }
#define MFMA16(a, b, c) __builtin_amdgcn_mfma_f32_16x16x32_bf16(a, b, c, 0, 0, 0)
#define MFMA32(a, b, c) __builtin_amdgcn_mfma_f32_32x32x16_bf16(a, b, c, 0, 0, 0)
#endif
__device__ __forceinline__ void st4bf(bf16_t* p, f32x4 v) { u32x2 w; w.x = cvtpk(v[0], v[1]); w.y = cvtpk(v[2], v[3]); *(GAS u32x2*)p = w; }
__device__ __forceinline__ f32x4 bf4(u32x2 w) { f32x4 r; r[0] = up_lo(w.x); r[1] = up_hi(w.x); r[2] = up_lo(w.y); r[3] = up_hi(w.y); return r; }
__device__ __forceinline__ f32x4 ld4bf(const bf16_t* p) { return bf4(*(const GAS u32x2*)p); }
#define swz_xor(v, pat) __builtin_bit_cast(float, __builtin_amdgcn_ds_swizzle(__builtin_bit_cast(int, (float)(v)), (pat)))
__device__ __forceinline__ void swap32(float& a, float& b) { asm volatile("s_nop 1\n\tv_permlane32_swap_b32 %0, %1" : "+v"(a), "+v"(b)); }
__device__ __forceinline__ float sum_halves(float v) { float a = v, b = v; swap32(a, b); return a + b; }
__device__ __forceinline__ float max_halves(float v) { float a = v, b = v; swap32(a, b); return fmaxf(a, b); }
__device__ __forceinline__ float other_half(float v, int hi) { float a = v, b = v; swap32(a, b); return hi ? a : b; }
#ifndef DBG_SHFL_SUM
#define DBG_SHFL_SUM 0
#endif
__device__ __forceinline__ float wave_sum(float v) {
#if DBG_SHFL_SUM
#pragma unroll
    for (int o = 1; o < 64; o <<= 1) v += __shfl_xor(v, o);
    return v;
#else
    v += swz_xor(v, (1 << 10) | 0x1f); v += swz_xor(v, (2 << 10) | 0x1f); v += swz_xor(v, (4 << 10) | 0x1f); v += swz_xor(v, (8 << 10) | 0x1f); v += swz_xor(v, (16 << 10) | 0x1f);
    return sum_halves(v);
#endif
}
#define LDS_WAIT() asm volatile("s_waitcnt lgkmcnt(0)" ::: "memory")
#define VM_WAIT() asm volatile("s_waitcnt vmcnt(0)" ::: "memory")

namespace pg8 {
constexpr int BM = 256, BK = 64, HALF = 128, HTB = HALF * BK * 2, STAGE_BYTES = 8 * HTB, NXCD = 8, WGM = 8;
__host__ __device__ __forceinline__ int lds_byte(int r, int c) { const int st = (r >> 4) * 2 + (c >> 5), rr = r & 15, cc = c & 31, ob = rr * 64 + cc * 2; return st * 1024 + (ob ^ (((ob >> 9) & 1) << 5)); }
__host__ __device__ __forceinline__ void stage_rc(int b, int& R, int& C) { const int st = b / 1024, sb = b % 1024, swz = sb ^ (((sb >> 9) & 1) << 5); R = (st >> 1) * 16 + swz / 64; C = (st & 1) * 32 + (swz % 64) / 2; }

struct Unit { int pm, pn, z; };
struct Gemm { const bf16_t* A; const bf16_t* Bt; const bf16_t* A2; const bf16_t* Bt2; int lda, ldb, K; };

struct StaticOrder {
    int nM, nN, nwg, G, c;
    __host__ __device__ void init(int M, int N, int G_, int c_) { nM = M / BM; nN = N / BM; nwg = nM * nN; G = G_; c = c_; }
    __host__ __device__ bool next(int i, Unit& u) const {
        const long L = (long)i * G + c; if (L >= nwg) return false;
        int wgid = (int)L; { const int q = nwg / NXCD, r = nwg % NXCD, xcd = wgid % NXCD, off = wgid / NXCD; wgid = (xcd < r ? xcd * (q + 1) : r * (q + 1) + (xcd - r) * q) + off; }
        const int nig = WGM * nN, gid = wgid / nig, fm = gid * WGM, gsz = (nM - fm) < WGM ? (nM - fm) : WGM;
        u.pm = fm + ((wgid % nig) % gsz); u.pn = (wgid % nig) / gsz; u.z = 0; return true;
    }
};
struct Order {
    StaticOrder s; int pair;
    __host__ __device__ bool next(int i, Unit& u) const { if (!s.next(pair ? (i >> 1) : i, u)) return false; u.z = pair ? (i & 1) : 0; return true; }
};

template <class F> struct Epi {
    F f;
    __device__ __forceinline__ void operator()(const f32x4 (&acc)[2][2][4][2], const Unit& u, int wr, int wc, int fr, int fq) const {
        { unsigned z_ = 0u; asm volatile("" : "+v"(z_)); const int l_ = (int)__builtin_amdgcn_mbcnt_hi(~0u, __builtin_amdgcn_mbcnt_lo(~0u, z_)); fr = l_ & 15; fq = l_ >> 4; }
        const int row0 = u.pm * BM + wr * 64 + fr;
        typename F::Row rw[8];
#pragma unroll
        for (int it = 0; it < 8; ++it) rw[it] = f.loadrow(u, row0 + (it >> 2) * HALF + (it & 3) * 16);
#pragma unroll
        for (int bj = 0; bj < 2; ++bj) {
            const int col = u.pn * BM + bj * HALF + wc * 32 + 4 * fq;
            const typename F::Ctx cx = f.prep(u, col);
            constexpr int PD = F::PD;
            typename F::Ld q[8];
#pragma unroll
            for (int it = 0; it < PD; ++it) q[it] = f.load(cx, u, row0 + (it >> 2) * HALF + (it & 3) * 16, col);
#pragma unroll
            for (int it = 0; it < 8; ++it) {
                const int ai = it >> 2, m = it & 3, row = row0 + ai * HALF + m * 16;
                if (it + PD < 8) q[it + PD] = f.load(cx, u, row0 + ((it + PD) >> 2) * HALF + ((it + PD) & 3) * 16, col);
                f.finish(cx, u, row, col, rw[it], q[it], acc[ai][bj][m][0], acc[ai][bj][m][1], fq);
                if (PD > 0) asm volatile("" ::: "memory");
            }
        }
        f.post(u, wr * 4 + wc, fr + 16 * fq);
    }
};

template <class EpiT, class Sched, bool ALIGN_EPI>
__device__ __forceinline__ void gemm_phase(LAS unsigned char* lds, int tid, const Gemm g, const Sched& S, const EpiT& E) {
    asm volatile("" : "+v"(tid));
    const int wid = __builtin_amdgcn_readfirstlane(tid >> 6), lane = tid & 63, wr = wid >> 2, wc = wid & 3, fr = lane & 15, fq = lane >> 4;
    const int K = g.K, nt = K / BK;
    unsigned voffA[2], voffB[2];
#pragma unroll
    for (int i = 0; i < 2; ++i) { int R, C; stage_rc(tid * 16 + i * 8192, R, C);
        voffA[i] = (unsigned)(R * g.lda + C) * 2u; voffB[i] = (unsigned)(R * g.ldb + C) * 2u; }
    const size_t kstep = (size_t)(BK * 2);
    const size_t hstepA = (size_t)HALF * g.lda * 2, hstepB = (size_t)HALF * g.ldb * 2;
    const size_t tstepA = 2 * hstepA, tstepB = 2 * hstepB;
    const unsigned ldsw = (unsigned)wid * 1024u;
    const int aoff = lds_byte(wr * 64 + fr, fq * 8), boff = lds_byte(wc * 32 + fr, fq * 8);
#define PG8_SA(b, h) (((b) * 2 + (h)) * HTB)
#define PG8_SB(b, h) ((4 + (b) * 2 + (h)) * HTB)
#define PG8_STAGE(bufoff, gbase, voff) do { _Pragma("unroll") for (int _i = 0; _i < 2; ++_i) \
        __builtin_amdgcn_global_load_lds((const unsigned*)((const char*)(gbase) + (voff)[_i]), (LAS unsigned*)(lds + (bufoff) + ldsw + _i * 8192), 16, 0, 0); } while (0)
#define PG8_LDA(dst, b, h) do { _Pragma("unroll") for (int m = 0; m < 4; ++m) _Pragma("unroll") for (int k = 0; k < 2; ++k) dst[m][k] = *(const LAS bf16x8*)(lds + PG8_SA(b, h) + aoff + m * 2048 + k * 1024); } while (0)
#define PG8_LDB(dst, b, h) do { _Pragma("unroll") for (int n = 0; n < 2; ++n) _Pragma("unroll") for (int k = 0; k < 2; ++k) dst[n][k] = *(const LAS bf16x8*)(lds + PG8_SB(b, h) + boff + n * 2048 + k * 1024); } while (0)
#define PG8_MMA(ai, bj, At, Bt) do { __builtin_amdgcn_s_setprio(1); _Pragma("unroll") for (int m = 0; m < 4; ++m) _Pragma("unroll") for (int n = 0; n < 2; ++n) _Pragma("unroll") for (int k = 0; k < 2; ++k) \
        acc[ai][bj][m][n] = MFMA16(Bt[n][k], At[m][k], acc[ai][bj][m][n]); __builtin_amdgcn_s_setprio(0); } while (0)
#define PG8_WAIT_V(n) asm volatile("s_waitcnt vmcnt(" #n ")" ::: "memory")
#define PG8_WAIT_L(n) asm volatile("s_waitcnt lgkmcnt(" #n ")" ::: "memory")
#define PG8_BAR __builtin_amdgcn_s_barrier()
#define PG8_SCHED __builtin_amdgcn_sched_barrier(0)
    Unit cur, nxt; int ui = 0;
    if (!S.next(0, cur)) return;
    f32x4 acc[2][2][4][2];
    { float zf = 0.f; asm volatile("" : "+v"(zf));
#pragma unroll
    for (int a = 0; a < 2; ++a)
#pragma unroll
        for (int b = 0; b < 2; ++b)
#pragma unroll
            for (int m = 0; m < 4; ++m)
#pragma unroll
                for (int n = 0; n < 2; ++n) acc[a][b][m][n] = (f32x4){zf, zf, zf, zf}; }
    bf16x8 At[4][2], B0[2][2], B1[2][2];
    const char* cA = (const char*)(cur.z ? g.A2 : g.A) + (size_t)cur.pm * tstepA; const char* cB = (const char*)(cur.z ? g.Bt2 : g.Bt) + (size_t)cur.pn * tstepB;
    PG8_STAGE(PG8_SB(0, 0), cB, voffB); PG8_STAGE(PG8_SB(0, 1), cB + hstepB, voffB); PG8_STAGE(PG8_SA(0, 0), cA, voffA); PG8_STAGE(PG8_SA(0, 1), cA + hstepA, voffA);
    if (wr == 1) PG8_BAR;
    PG8_WAIT_V(2); PG8_BAR;
    PG8_STAGE(PG8_SB(1, 0), cB + kstep, voffB); PG8_STAGE(PG8_SA(1, 0), cA + kstep, voffA); PG8_STAGE(PG8_SB(1, 1), cB + hstepB + kstep, voffB);
    PG8_WAIT_V(6); PG8_BAR;
    for (;;) {
        const bool has_next = S.next(ui + 1, nxt);
        const char* nA = has_next ? (const char*)(nxt.z ? g.A2 : g.A) + (size_t)nxt.pm * tstepA : cA; const char* nB = has_next ? (const char*)(nxt.z ? g.Bt2 : g.Bt) + (size_t)nxt.pn * tstepB : cB;
        for (int t = 0; t < nt; t += 2) {
            const bool last = (t == nt - 2);
            const char* a1 = cA + (size_t)(t + 1) * kstep;
            const char* a2 = last ? nA : cA + (size_t)(t + 2) * kstep; const char* b2 = last ? nB : cB + (size_t)(t + 2) * kstep;
            const char* a3 = a2 + kstep; const char* b3 = b2 + kstep;
            PG8_LDB(B0, 0, 0); PG8_LDB(B1, 0, 1); PG8_SCHED; PG8_LDA(At, 0, 0); PG8_STAGE(PG8_SA(1, 1), a1 + hstepA, voffA);
            PG8_WAIT_V(8); PG8_WAIT_L(0); PG8_BAR; PG8_MMA(0, 0, At, B0); PG8_MMA(0, 1, At, B1); PG8_BAR; PG8_SCHED;
            PG8_LDA(At, 0, 1); PG8_STAGE(PG8_SB(0, 0), b2, voffB); PG8_STAGE(PG8_SB(0, 1), b2 + hstepB, voffB); PG8_STAGE(PG8_SA(0, 0), a2, voffA);
            PG8_WAIT_V(8); PG8_WAIT_L(0); PG8_BAR; PG8_MMA(1, 0, At, B0); PG8_MMA(1, 1, At, B1); PG8_BAR; PG8_SCHED;
            PG8_LDB(B0, 1, 0); PG8_LDB(B1, 1, 1); PG8_SCHED; PG8_LDA(At, 1, 0); PG8_STAGE(PG8_SA(0, 1), a2 + hstepA, voffA);
            PG8_WAIT_V(8); PG8_WAIT_L(0); PG8_BAR; PG8_MMA(0, 0, At, B0); PG8_MMA(0, 1, At, B1); PG8_BAR; PG8_SCHED;
            PG8_LDA(At, 1, 1); PG8_STAGE(PG8_SB(1, 0), b3, voffB); PG8_STAGE(PG8_SB(1, 1), b3 + hstepB, voffB); PG8_STAGE(PG8_SA(1, 0), a3, voffA);
            PG8_WAIT_V(8); PG8_WAIT_L(0); PG8_BAR; PG8_MMA(1, 0, At, B0); PG8_MMA(1, 1, At, B1); PG8_BAR; PG8_SCHED;
        }
        if constexpr (ALIGN_EPI) { if (wr == 0) PG8_BAR; }
        E(acc, cur, wr, wc, fr, fq);
        if (!has_next) break;
        { float zf = 0.f; asm volatile("" : "+v"(zf));
#pragma unroll
        for (int a = 0; a < 2; ++a)
#pragma unroll
            for (int b = 0; b < 2; ++b)
#pragma unroll
                for (int m = 0; m < 4; ++m)
#pragma unroll
                    for (int n = 0; n < 2; ++n) acc[a][b][m][n] = (f32x4){zf, zf, zf, zf}; }
        cur = nxt; cA = nA; cB = nB; ++ui;
        if constexpr (ALIGN_EPI) { if (wr == 1) PG8_BAR; }
    }
    PG8_WAIT_V(0);
    if constexpr (!ALIGN_EPI) { if (wr == 0) PG8_BAR; }
    PG8_BAR;
#undef PG8_SA
#undef PG8_SB
#undef PG8_STAGE
#undef PG8_LDA
#undef PG8_LDB
#undef PG8_MMA
#undef PG8_WAIT_V
#undef PG8_WAIT_L
#undef PG8_BAR
#undef PG8_SCHED
}
}

__device__ __forceinline__ float sum_fq(float v) { v += swz_xor(v, (16 << 10) | 0x1f); return sum_halves(v); }
__device__ __forceinline__ float dot4(f32x4 a) { return (a[0] * a[0] + a[1] * a[1]) + (a[2] * a[2] + a[3] * a[3]); }
struct LdNone { int d; };
struct F_ProjA {
    bf16_t* P; const float* xstat; const float* sv; float* lstat; bf16_t* kpe; const float* cosT; const float* sinT;
    struct Ctx { float sc; f32x4 s0, s1; int grp; }; struct Ld { f32x4 ct, sn; }; struct Row { float rs; }; static constexpr int PD = 1;
    __device__ __forceinline__ Row loadrow(const pg8::Unit&, int row) const { const f32x4 xs = *(const GAS f32x4*)(xstat + (size_t)row * 4); Row r; r.rs = 1.0f / sqrtf(((xs[0] + xs[1]) + (xs[2] + xs[3])) * (1.0f / DM) + NORM_EPS); return r; }
    __device__ __forceinline__ Ctx prep(const pg8::Unit& u, int col) const { Ctx c; c.sc = (u.pn < 2) ? C2SB : 1.0f; const float* sp = sv + (size_t)(u.pm >> 3) * NPJ + col;
        c.s0 = *(const GAS f32x4*)sp; c.s1 = *(const GAS f32x4*)(sp + 16); c.grp = col >> 5; return c; }
    __device__ __forceinline__ Ld load(const Ctx& c, const pg8::Unit&, int row, int col) const { Ld l; l.ct = c.s0; l.sn = c.s0;
        if (c.grp == (C_KROPE >> 5)) { l.ct = *(const GAS f32x4*)(cosT + (size_t)row * 16 + (col & 15)); l.sn = *(const GAS f32x4*)(sinT + (size_t)row * 16 + (col & 15)); } return l; }
    __device__ __forceinline__ void finish(const Ctx& c, const pg8::Unit&, int row, int col, const Row& rw, const Ld& l, f32x4 v0, f32x4 v1, int fq) const {
        v0 = v0 * rw.rs + c.s0; v1 = v1 * rw.rs + c.s1;
        if (c.grp >= (C_QLAT >> 5) && c.grp < (C_KROPE >> 5)) {
            const float ss = sum_fq(dot4(v0) + dot4(v1));
            if (fq == 0) ((GAS float*)lstat)[(size_t)row * 24 + (c.grp - (C_QLAT >> 5))] = ss;
        }
        if (c.grp == (C_KROPE >> 5)) {
            const f32x4 a = v0 * l.ct - v1 * l.sn, b = v1 * l.ct + v0 * l.sn;
            bf16_t* ko = kpe + (size_t)row * 32 + (col & 15); st4bf(ko, a); st4bf(ko + 16, b);
        }
        bf16_t* o = P + (size_t)row * NPJ + col; st4bf(o, v0 * c.sc); st4bf(o + 16, v1 * c.sc); }
    __device__ __forceinline__ void post(const pg8::Unit&, int, int) const {}
};
struct F_Qup {
    bf16_t* Q; const float* cosT; const float* sinT; const float* lstat;
    struct Ctx { int rope; }; struct Ld { f32x4 a, b, c, ct, st; }; typedef LdNone Row; static constexpr int PD = 1;
    __device__ __forceinline__ Row loadrow(const pg8::Unit&, int) const { Row r; r.d = 0; return r; }
    __device__ __forceinline__ Ctx prep(const pg8::Unit&, int col) const { Ctx c; c.rope = (((col >> 5) % 3) == 2) ? 1 : 0; return c; }
    __device__ __forceinline__ Ld load(const Ctx&, const pg8::Unit&, int row, int col) const { Ld l; const int i0 = col & 15; const float* ls = lstat + (size_t)row * 24;
        l.a = *(const GAS f32x4*)ls; l.b = *(const GAS f32x4*)(ls + 4); l.c = *(const GAS f32x4*)(ls + 8);
        l.ct = *(const GAS f32x4*)(cosT + (size_t)row * 16 + i0); l.st = *(const GAS f32x4*)(sinT + (size_t)row * 16 + i0); return l; }
    __device__ __forceinline__ void finish(const Ctx& c, const pg8::Unit&, int row, int col, const Row&, const Ld& l, f32x4 v0, f32x4 v1, int) const {
        const f32x4 t = l.a + l.b + l.c; const float rs = 1.0f / sqrtf(((t[0] + t[1]) + (t[2] + t[3])) * (1.0f / QRANK) + NORM_EPS);
        v0 = v0 * rs; v1 = v1 * rs;
        if (c.rope) { const f32x4 a = v0 * l.ct - v1 * l.st, b = v1 * l.ct + v0 * l.st; v0 = a; v1 = b; }
        bf16_t* o = Q + (size_t)row * QFULL + col; st4bf(o, v0 * C2MLA); st4bf(o + 16, v1 * C2MLA); }
    __device__ __forceinline__ void post(const pg8::Unit&, int, int) const {}
};
struct F_Kvup {
    bf16_t* KV; const float* lstat;
    struct Ctx { int d; }; struct Ld { f32x4 a, b; }; typedef LdNone Row; static constexpr int PD = 1;
    __device__ __forceinline__ Row loadrow(const pg8::Unit&, int) const { Row r; r.d = 0; return r; }
    __device__ __forceinline__ Ctx prep(const pg8::Unit&, int) const { Ctx c; c.d = 0; return c; }
    __device__ __forceinline__ Ld load(const Ctx&, const pg8::Unit&, int row, int) const { Ld l; const float* ls = lstat + (size_t)row * 24 + 12; l.a = *(const GAS f32x4*)ls; l.b = *(const GAS f32x4*)(ls + 4); return l; }
    __device__ __forceinline__ void finish(const Ctx&, const pg8::Unit&, int row, int col, const Row&, const Ld& l, f32x4 v0, f32x4 v1, int) const {
        const f32x4 t = l.a + l.b; const float rs = 1.0f / sqrtf(((t[0] + t[1]) + (t[2] + t[3])) * (1.0f / KVRANK) + NORM_EPS);
        bf16_t* o = KV + (size_t)row * KVW + col; st4bf(o, v0 * rs); st4bf(o + 16, v1 * rs); }
    __device__ __forceinline__ void post(const pg8::Unit&, int, int) const {}
};
__device__ __forceinline__ f32x4 sigmoid4(f32x4 g) { f32x4 r;
#pragma unroll
    for (int i = 0; i < 4; ++i) r[i] = __builtin_amdgcn_rcpf(1.0f + __builtin_amdgcn_exp2f(-LOG2E * g[i]));
    return r; }
struct F_Gate {
    const bf16_t* P; bf16_t* Mg;
    struct Ctx { int goff; }; struct Ld { u32x2 g0, g1, m0, m1; }; typedef LdNone Row; static constexpr int PD = 2;
    __device__ __forceinline__ Row loadrow(const pg8::Unit&, int) const { Row r; r.d = 0; return r; }
    __device__ __forceinline__ Ctx prep(const pg8::Unit& u, int) const { Ctx c; c.goff = u.z ? C_GMLA : C_GSB; return c; }
    __device__ __forceinline__ Ld load(const Ctx& c, const pg8::Unit& u, int row, int col) const { Ld l; const bf16_t* gp = P + (size_t)row * NPJ + c.goff + col;
        l.g0 = *(const GAS u32x2*)gp; l.g1 = *(const GAS u32x2*)(gp + 16); l.m0 = l.g0; l.m1 = l.g1;
        if (u.z) { const bf16_t* o = Mg + (size_t)row * DM + col; l.m0 = *(const GAS u32x2*)o; l.m1 = *(const GAS u32x2*)(o + 16); } return l; }
    __device__ __forceinline__ void finish(const Ctx&, const pg8::Unit& u, int row, int col, const Row&, const Ld& l, f32x4 v0, f32x4 v1, int) const {
        bf16_t* o = Mg + (size_t)row * DM + col;
        f32x4 r0 = sigmoid4(bf4(l.g0)) * v0, r1 = sigmoid4(bf4(l.g1)) * v1;
        if (u.z) { r0 += bf4(l.m0); r1 += bf4(l.m1); }
        st4bf(o, r0); st4bf(o + 16, r1); }
    __device__ __forceinline__ void post(const pg8::Unit&, int, int) const {}
};
struct F_Resid {
    const float* base; float* X; const float* gate; const float* gn; const float* scn; bf16_t* XG; float* xstat; LAS float* part;
    struct Ctx { f32x4 g0, g1, m0, m1; int slot; }; struct Ld { f32x4 b0, b1; }; typedef LdNone Row; static constexpr int PD = 2;
    __device__ __forceinline__ Row loadrow(const pg8::Unit&, int) const { Row r; r.d = 0; return r; }
    __device__ __forceinline__ Ctx prep(const pg8::Unit& u, int col) const { Ctx c; const size_t bo = (size_t)(u.pm >> 3) * (6 * DM) + col; const float* gp = gate + bo; c.g0 = *(const GAS f32x4*)gp; c.g1 = *(const GAS f32x4*)(gp + 16);
        const float* sp = scn + bo; c.m0 = *(const GAS f32x4*)(gn + col) * (1.0f + *(const GAS f32x4*)sp); c.m1 = *(const GAS f32x4*)(gn + col + 16) * (1.0f + *(const GAS f32x4*)(sp + 16));
        c.slot = (col >> 5) & 7; return c; }
    __device__ __forceinline__ Ld load(const Ctx&, const pg8::Unit&, int row, int col) const { Ld l; const size_t off = (size_t)row * DM + col; l.b0 = *(const GAS f32x4*)(base + off); l.b1 = *(const GAS f32x4*)(base + off + 16); return l; }
    __device__ __forceinline__ void finish(const Ctx& c, const pg8::Unit&, int row, int col, const Row&, const Ld& l, f32x4 v0, f32x4 v1, int fq) const {
        const size_t off = (size_t)row * DM + col;
        const f32x4 x0 = l.b0 + c.g0 * v0, x1 = l.b1 + c.g1 * v1;
        *(GAS f32x4*)(X + off) = x0; *(GAS f32x4*)(X + off + 16) = x1;
        st4bf(XG + off, x0 * c.m0); st4bf(XG + off + 16, x1 * c.m1);
        const float ss = sum_fq(dot4(x0) + dot4(x1));
        if (fq == 0) part[(row & 255) * 8 + c.slot] = ss; }
    __device__ __forceinline__ void post(const pg8::Unit& u, int wave, int lane) const {
        asm volatile("s_waitcnt lgkmcnt(0)" ::: "memory"); __builtin_amdgcn_s_barrier(); asm volatile("" ::: "memory");
        if (wave < 4) { const int r = wave * 64 + lane; const LAS float* p = part + r * 8;
            ((GAS float*)xstat)[(size_t)(u.pm * 256 + r) * 4 + u.pn] = ((p[0] + p[1]) + (p[2] + p[3])) + ((p[4] + p[5]) + (p[6] + p[7])); }
        asm volatile("s_waitcnt lgkmcnt(0)" ::: "memory"); __builtin_amdgcn_s_barrier(); asm volatile("" ::: "memory");
    }
};
struct F_Sqrelu {
    bf16_t* U; const float* xstat; const float* sv;
    struct Ctx { f32x4 s0, s1; }; typedef LdNone Ld; struct Row { float rs; }; static constexpr int PD = 0;
    __device__ __forceinline__ Row loadrow(const pg8::Unit&, int row) const { const f32x4 xs = *(const GAS f32x4*)(xstat + (size_t)row * 4); Row r; r.rs = 1.0f / sqrtf(((xs[0] + xs[1]) + (xs[2] + xs[3])) * (1.0f / DM) + NORM_EPS); return r; }
    __device__ __forceinline__ Ctx prep(const pg8::Unit& u, int col) const { Ctx c; const float* sp = sv + (size_t)(u.pm >> 3) * FF + col; c.s0 = *(const GAS f32x4*)sp; c.s1 = *(const GAS f32x4*)(sp + 16); return c; }
    __device__ __forceinline__ Ld load(const Ctx&, const pg8::Unit&, int, int) const { Ld l; l.d = 0; return l; }
    __device__ __forceinline__ void finish(const Ctx& c, const pg8::Unit&, int row, int col, const Row& rw, const Ld&, f32x4 v0, f32x4 v1, int) const {
        const float rs = rw.rs;
        const f32x4 z = {0.f, 0.f, 0.f, 0.f};
        f32x4 a = __builtin_elementwise_max(v0 * rs + c.s0, z), b = __builtin_elementwise_max(v1 * rs + c.s1, z);
        bf16_t* o = U + (size_t)row * FF + col; st4bf(o, a * a); st4bf(o + 16, b * b); }
    __device__ __forceinline__ void post(const pg8::Unit&, int, int) const {}
};

struct EpiAll {
    int kind; unsigned char* ws; float* xo; const float* base; const float* gate; const float* gn; const float* scn; const float* sv; LAS float* part;
    template <class F> __device__ __forceinline__ void run(const F& f, const f32x4 (&acc)[2][2][4][2], const pg8::Unit& u, int wr, int wc) const { pg8::Epi<F> e{f}; e(acc, u, wr, wc, 0, 0); }
    __device__ __forceinline__ void operator()(const f32x4 (&acc)[2][2][4][2], const pg8::Unit& u, int wr, int wc, int, int) const {
        const float* cosT = (const float*)(ws + WS_COS); const float* sinT = (const float*)(ws + WS_SIN); float* xstat = (float*)(ws + WS_XSTAT); float* lstat = (float*)(ws + WS_LSTAT);
        if (kind == 0) run(F_ProjA{(bf16_t*)(ws + WS_P), xstat, sv, lstat, (bf16_t*)(ws + WS_KPE), cosT, sinT}, acc, u, wr, wc);
        else if (kind == 1) run(F_Qup{(bf16_t*)(ws + WS_QF), cosT, sinT, lstat}, acc, u, wr, wc);
        else if (kind == 2) run(F_Kvup{(bf16_t*)(ws + WS_KV), lstat}, acc, u, wr, wc);
        else if (kind == 3) run(F_Gate{(const bf16_t*)(ws + WS_P), (bf16_t*)(ws + WS_QF)}, acc, u, wr, wc);
        else if (kind == 4) run(F_Resid{base, xo, gate, gn, scn, (bf16_t*)(ws + WS_H), xstat, part}, acc, u, wr, wc);
        else run(F_Sqrelu{(bf16_t*)(ws + WS_P), xstat, sv}, acc, u, wr, wc);
    }
};

__device__ __forceinline__ int crow(int r, int hi) { return (r & 3) + 8 * (r >> 2) + 4 * hi; }
typedef short v4i16_t __attribute__((ext_vector_type(4)));
__device__ __forceinline__ s16x4 vtr(const LAS unsigned char* p) { return __builtin_bit_cast(s16x4, __builtin_amdgcn_ds_read_tr16_b64_v4i16((LAS v4i16_t*)p)); }

__device__ __forceinline__ float prod_halves(float v) { float a = v, b = v; swap32(a, b); return a * b; }
template <bool DIAG>
__device__ __forceinline__ void sb_half(const f32x16& y16, float& Rp, int kb, int tq, int hi, u32x4& pwa, u32x4& pwb) {
    float s[16], f[16];
#pragma unroll
    for (int r = 0; r < 16; ++r) {
        const float y = y16[r];
        const float e = __builtin_amdgcn_exp2f(-fabsf(y));
        const float rr = __builtin_amdgcn_rcpf(1.0f + e), er = e * rr;
        const bool pos = y >= 0.f;
        float sg = pos ? rr : er, fl = pos ? er : rr;
        if (DIAG) { const bool valid = (kb + crow(r, hi)) < tq; sg = valid ? sg : 0.f; fl = valid ? fl : 1.0f; }
        s[r] = sg; f[r] = fl;
    }
    float G[4], OS[4];
#pragma unroll
    for (int g = 0; g < 4; ++g) G[g] = (f[4 * g] * f[4 * g + 1]) * (f[4 * g + 2] * f[4 * g + 3]);
    OS[3] = G[3];
#pragma unroll
    for (int g = 2; g >= 0; --g) OS[g] = G[g] * OS[g + 1];
    const float T = prod_halves(OS[0]);
#pragma unroll
    for (int g = 0; g < 4; ++g) {
        const float ex = (g < 3) ? OS[g + 1] : 1.0f;
        const float snd = hi ? OS[g] : ex;
        const float rcv = other_half(snd, hi);
        float w = (Rp * ex) * rcv;
        const float a3 = s[4 * g + 3] * w; w *= f[4 * g + 3];
        const float a2 = s[4 * g + 2] * w; w *= f[4 * g + 2];
        const float a1 = s[4 * g + 1] * w; w *= f[4 * g + 1];
        const float a0 = s[4 * g] * w;
        const unsigned lo = cvtpk(a0, a1), up = cvtpk(a2, a3);
        if (g == 0) { pwa[0] = lo; pwa[1] = up; } else if (g == 1) { pwa[2] = lo; pwa[3] = up; } else if (g == 2) { pwb[0] = lo; pwb[1] = up; } else { pwb[2] = lo; pwb[3] = up; }
    }
    Rp *= T;
}
template <bool DIAG>
__device__ __forceinline__ float sm_weights(f32x16& p0, f32x16& p1, float& m, float& l, int kb, int tq, int hi, u32x4 (&pw)[4]) {
    if (DIAG) {
#pragma unroll
        for (int r = 0; r < 16; ++r) { const int key = kb + crow(r, hi); if (key > tq) p0[r] = -INFINITY; if (key + 32 > tq) p1[r] = -INFINITY; }
    }
    float mx = fmaxf(p0[0], p1[0]);
#pragma unroll
    for (int r = 1; r < 16; ++r) mx = fmaxf(mx, fmaxf(p0[r], p1[r]));
    mx = max_halves(mx);
    const float mn = fmaxf(m, mx), alpha = __builtin_amdgcn_exp2f(m - mn);
    m = mn;
    float sum = 0.f;
#pragma unroll
    for (int j = 0; j < 8; ++j) {
        const float a = __builtin_amdgcn_exp2f(p0[2 * j] - mn), b = __builtin_amdgcn_exp2f(p0[2 * j + 1] - mn), c = __builtin_amdgcn_exp2f(p1[2 * j] - mn), d = __builtin_amdgcn_exp2f(p1[2 * j + 1] - mn);
        sum += (a + b) + (c + d);
        pw[j >> 2][j & 3] = cvtpk(a, b); pw[2 + (j >> 2)][j & 3] = cvtpk(c, d);
    }
    l = l * alpha + sum;
    return alpha;
}

template <bool MLA>
__device__ __forceinline__ void attn_tile(const LAS unsigned char* Kb, const LAS unsigned char* Vb, const bf16x8 (&qr)[MLA ? 6 : 4], f32x16& o0, f32x16& o1, float& R, float& m_run, float& l_run,
                                          int kb, int tq, int hi, bool diag) {
    constexpr int NKS = MLA ? 6 : 4;
    u32x4 pw[4];
    if (MLA) {
        f32x16 p0, p1;
#pragma unroll
        for (int r = 0; r < 16; ++r) { p0[r] = 0.f; p1[r] = 0.f; }
#pragma unroll
        for (int ks = 0; ks < NKS; ++ks) {
            const bf16x8 k0 = *(const LAS bf16x8*)(Kb + ks * 2048), k1 = *(const LAS bf16x8*)(Kb + ks * 2048 + 512);
            p0 = MFMA32(k0, qr[ks], p0); p1 = MFMA32(k1, qr[ks], p1);
        }
        float alpha;
        if (diag) alpha = sm_weights<true>(p0, p1, m_run, l_run, kb, tq, hi, pw); else alpha = sm_weights<false>(p0, p1, m_run, l_run, kb, tq, hi, pw);
#pragma unroll
        for (int r = 0; r < 16; ++r) { o0[r] *= alpha; o1[r] *= alpha; }
    } else {
#pragma unroll
        for (int sub = 1; sub >= 0; --sub) {
            f32x16 p;
#pragma unroll
            for (int r = 0; r < 16; ++r) p[r] = 0.f;
#pragma unroll
            for (int ks = 0; ks < NKS; ++ks) { const bf16x8 kf = *(const LAS bf16x8*)(Kb + ks * 2048 + sub * 512); p = MFMA32(kf, qr[ks], p); }
            if (diag) sb_half<true>(p, R, kb + 32 * sub, tq, hi, pw[2 * sub], pw[2 * sub + 1]); else sb_half<false>(p, R, kb + 32 * sub, tq, hi, pw[2 * sub], pw[2 * sub + 1]);
        }
    }
#pragma unroll
    for (int ks = 0; ks < 4; ++ks) {
        const bf16x8 pa = __builtin_bit_cast(bf16x8, pw[ks]);
        const s16x4 a0 = vtr(Vb + ks * 1024), a1 = vtr(Vb + ks * 1024 + 512), c0 = vtr(Vb + 4096 + ks * 1024), c1 = vtr(Vb + 4096 + ks * 1024 + 512);
        const bf16x8 v0 = {a0[0], a0[1], a0[2], a0[3], a1[0], a1[1], a1[2], a1[3]}, v1 = {c0[0], c0[1], c0[2], c0[3], c1[0], c1[1], c1[2], c1[3]};
        o0 = MFMA32(v0, pa, o0); o1 = MFMA32(v1, pa, o1);
    }
}

struct AttnStage { u32x4 k, v, k2; };
template <bool MLA>
__device__ __forceinline__ void attn_unit(LAS unsigned char* lds, int tid, int b, int qb,
                                          const bf16_t* Qp, int qpitch, int qoff, const bf16_t* Kp, int kpitch, int koff, const bf16_t* KPE,
                                          const bf16_t* Vp, int vpitch, int voff, bf16_t* Op, int opitch, int ooff, unsigned* dbg_ctr = nullptr) {
    asm volatile("" : "+v"(tid));
    constexpr int NKS = MLA ? 6 : 4;
    constexpr int BUFB = 20480, VOFF = 12288;
    const int lane = tid & 63, r32 = lane & 31, hi = lane >> 5;
    const int wid = __builtin_amdgcn_readfirstlane(tid >> 6);
    const size_t rowbase = (size_t)b * SEQ;
    const int q0 = qb * 256, tq = q0 + wid * 32 + r32, nt = 4 * qb + 4, wlast = 4 * qb + (wid >> 1);
    bf16x8 qr[NKS];
    { const bf16_t* qrow = Qp + (rowbase + tq) * qpitch + qoff + hi * 8;
#pragma unroll
      for (int ks = 0; ks < NKS; ++ks) qr[ks] = *(const GAS bf16x8*)(qrow + ks * 16); }
    const bf16_t* ksrc = Kp + (rowbase + lane) * kpitch + koff + wid * 8;
    const bf16_t* k2src = KPE + (rowbase + lane) * 32 + (wid & 3) * 8;
    const bf16_t* vsrc = Vp + (rowbase + 16 * (wid & 3) + (lane >> 2)) * vpitch + voff + (wid >> 2) * 32 + (lane & 3) * 8;
    const int kdst = wid * 1024 + lane * 16, k2dst = (8 + (wid & 3)) * 1024 + lane * 16, vdst = VOFF + wid * 1024 + lane * 16;
    const int kfrag = hi * 1024 + r32 * 16;
    const int vfrag = VOFF + ((lane >> 4) & 1) * 32 + (lane & 3) * 8 + (4 * hi + ((lane & 15) >> 2)) * 64;
    f32x16 o0, o1;
#pragma unroll
    for (int r = 0; r < 16; ++r) { o0[r] = 0.f; o1[r] = 0.f; }
    float R = 1.0f, m_run = -INFINITY, l_run = 0.f;
    AttnStage RA, RB;
#define TILE_OF(i) (MLA ? (i) : (nt - 1 - (i)))
#define LOADT(S, kt) do { S.k = *(const GAS u32x4*)(ksrc + (size_t)(kt) * 64 * kpitch); S.v = *(const GAS u32x4*)(vsrc + (size_t)(kt) * 64 * vpitch); \
        if (MLA) S.k2 = *(const GAS u32x4*)(k2src + (size_t)(kt) * 64 * 32); } while (0)
#define WRITET(S, bo) do { *(LAS u32x4*)(lds + (bo) + kdst) = S.k; *(LAS u32x4*)(lds + (bo) + vdst) = S.v; \
        if (MLA && wid < 4) *(LAS u32x4*)(lds + (bo) + k2dst) = S.k2; } while (0)
    constexpr float SB_EXIT = 3.5527136788005009e-15f;
    volatile LAS unsigned* cnt = (volatile LAS unsigned*)(lds + 3 * BUFB);
    if (!MLA && tid == 0) { cnt[0] = 0u; cnt[1] = 0u; cnt[2] = 0u; }
    bool wdone = false, stop = false; int ci = 0, bcur = 0; int dbg_iters = 0; (void)dbg_iters;
#define STEP(i_, SL, SW) do { const int i = (i_); const int kt = TILE_OF(i); const int cn = (ci == 2) ? 0 : ci + 1; const int bnext = (bcur == 2 * BUFB) ? 0 : bcur + BUFB; \
        if (!MLA && tid == 0) cnt[cn] = 0u; \
        if (i + 2 < nt) LOADT(SL, TILE_OF(i + 2)); \
        if (kt <= wlast && !wdone) { \
            attn_tile<MLA>(lds + bcur + kfrag, lds + bcur + vfrag, qr, o0, o1, R, m_run, l_run, kt * 64, tq, hi, kt == wlast); \
            if (!MLA) wdone = (__builtin_amdgcn_ballot_w64(R > SB_EXIT) == 0ull); } \
        if (!MLA && wdone && lane == 0) __hip_atomic_fetch_add((LAS unsigned*)(lds + 3 * BUFB) + ci, 1u, __ATOMIC_RELAXED, __HIP_MEMORY_SCOPE_WORKGROUP); \
        if (i + 1 < nt) WRITET(SW, bnext); \
        __syncthreads(); \
        if (!MLA) { if (cnt[ci] == (unsigned)NWAVES) stop = true; ci = cn; } \
        bcur = bnext; dbg_iters++; } while (0)
    LOADT(RA, TILE_OF(0)); WRITET(RA, 0); LOADT(RB, TILE_OF(1)); __syncthreads();
    for (int i2 = 0; i2 < nt; i2 += 2) {
        STEP(i2, RA, RB); if (stop) break;
        STEP(i2 + 1, RB, RA); if (stop) break;
    }
    if (!MLA) __syncthreads();
#ifdef DBG_STAT
    if (!MLA && tid == 0) atomicAdd(dbg_ctr, (unsigned)(bcur == 0 ? 0 : 0) + (unsigned)dbg_iters);
#endif
#undef STEP
#undef TILE_OF
#undef LOADT
#undef WRITET
    if (MLA) { const float lt = sum_halves(l_run); const float inv = 1.0f / lt;
#pragma unroll
        for (int r = 0; r < 16; ++r) { o0[r] *= inv; o1[r] *= inv; } }
    bf16_t* orow = Op + (rowbase + tq) * opitch + ooff + 4 * hi;
#pragma unroll
    for (int g = 0; g < 4; ++g) {
        st4bf(orow + 8 * g, (f32x4){o0[4 * g], o0[4 * g + 1], o0[4 * g + 2], o0[4 * g + 3]});
        st4bf(orow + 32 + 8 * g, (f32x4){o1[4 * g], o1[4 * g + 1], o1[4 * g + 2], o1[4 * g + 3]});
    }
}

#ifndef DBG_NAIVE_SB
#define DBG_NAIVE_SB 0
#endif
#ifndef DBG_NAIVE_MLA
#define DBG_NAIVE_MLA 0
#endif
template <bool MLA>
__device__ __forceinline__ void naive_attn(int gtid, int nthreads, const bf16_t* Qp, int qpitch, int qstride_h, const bf16_t* Kp, int kpitch, int kstride_h, int koff0, const bf16_t* KPE,
                                           const bf16_t* Vp, int vpitch, int vstride_h, int voff0, bf16_t* Op) {
    constexpr int DK = MLA ? 96 : 64;
    for (int idx = gtid; idx < NB * 8 * SEQ; idx += nthreads) {
        const int t = idx % SEQ, h = (idx / SEQ) % 8, b = idx / (SEQ * 8);
        const size_t rowbase = (size_t)b * SEQ;
        float q[DK];
#pragma unroll
        for (int d = 0; d < DK; ++d) q[d] = bf2f(((const GAS bf16_t*)Qp)[(rowbase + t) * qpitch + h * qstride_h + d]);
        float o[64];
#pragma unroll
        for (int d = 0; d < 64; ++d) o[d] = 0.f;
        float R = 0.f, m = -INFINITY, l = 0.f;
        const int s_top = __builtin_amdgcn_readfirstlane(t & ~63) + 63;
        for (int s = s_top; s >= 0; --s) {
            const bool valid = MLA ? (s <= t) : (s < t);
            const GAS bf16_t* kr = (const GAS bf16_t*)Kp + (rowbase + s) * kpitch + koff0 + h * kstride_h;
            float y = 0.f;
#pragma unroll
            for (int d = 0; d < 64; ++d) y += q[d] * bf2f(kr[d]);
            if (MLA) {
                const GAS bf16_t* kp2 = (const GAS bf16_t*)KPE + (rowbase + s) * 32;
#pragma unroll
                for (int d = 0; d < 32; ++d) y += q[64 + d] * bf2f(kp2[d]);
            }
            float w = 0.f;
            if (MLA) {
                if (valid) { const float mn = fmaxf(m, y), al = exp2f(m - mn); w = exp2f(y - mn); l = l * al + w; m = mn;
#pragma unroll
                    for (int d = 0; d < 64; ++d) o[d] *= al; }
            } else {
                if (valid) { const float sp = fmaxf(y, 0.f) + log2f(1.0f + exp2f(-fabsf(y))); w = exp2f((y - sp) + R); R -= sp; }
            }
            const GAS bf16_t* vr = (const GAS bf16_t*)Vp + (rowbase + s) * vpitch + voff0 + h * vstride_h;
#pragma unroll
            for (int d = 0; d < 64; ++d) o[d] += w * bf2f(vr[d]);
        }
        const float inv = MLA ? 1.0f / l : 1.0f;
#pragma unroll
        for (int d = 0; d < 64; d += 2) { const unsigned pk = cvtpk(o[d] * inv, o[d + 1] * inv); *(GAS unsigned*)(Op + (rowbase + t) * 512 + h * 64 + d) = pk; }
    }
}

typedef GAS unsigned gu32;
#define RLX_AGENT __ATOMIC_RELAXED, __HIP_MEMORY_SCOPE_AGENT
#define XB_TMO      128
#define XB_XCNT(j)  (256  + 64 * (j))
#define XB_XSUB(j)  (1280 + 64 * (j))
#define XB_XGEN(j)  (2304 + 64 * (j))
#define XB_TOP      3328
#define XB_TOPGEN   3392
#define XCD_BAR_WORDS 3456
#define XB_SPIN_CAP (1u << 18)
constexpr int CW_BAR = 4096;
constexpr int CW_QUEUE = 200000;
__device__ __forceinline__ unsigned xb_ld(unsigned* p)              { return __hip_atomic_load(p, __ATOMIC_RELAXED, __HIP_MEMORY_SCOPE_AGENT); }
__device__ __forceinline__ unsigned xb_add(unsigned* p, unsigned v) { return __hip_atomic_fetch_add(p, v, __ATOMIC_RELAXED, __HIP_MEMORY_SCOPE_AGENT); }
__device__ __forceinline__ unsigned xb_xcc_id() { return (unsigned)__builtin_amdgcn_s_getreg((3 << 11) | 20) & 0xFu; }
#define XB_SPIN(cond, bar) do { unsigned _sp = 0; while (cond) { __builtin_amdgcn_s_sleep(1); \
    if ((++_sp & 255u) == 0u) { if (xb_ld(&(bar)[XB_TMO])) break; if (_sp > XB_SPIN_CAP) { atomicAdd(&(bar)[XB_TMO], 1u); break; } } } } while (0)
struct XcdBarrier { unsigned* bar; unsigned x; volatile LAS unsigned* st; };
__device__ __forceinline__ XcdBarrier xcd_barrier_post(unsigned* bar, volatile LAS unsigned* st) {
    XcdBarrier b; b.bar = bar; b.x = xb_xcc_id(); b.st = st;
    if (threadIdx.x == 0) (void)xb_add(&bar[XB_XCNT(b.x)], 1u);
    return b;
}
__device__ __forceinline__ void xcd_barrier_complete(unsigned* bar, unsigned x, unsigned& nloc, unsigned& nx) {
    const unsigned G = gridDim.x * gridDim.y * gridDim.z;
    unsigned sum, cnt, mine, sp = 0u;
    for (;;) {
        sum = 0u; cnt = 0u; mine = 0u;
#pragma unroll 1
        for (unsigned j = 0; j < 16; ++j) { const unsigned c = xb_ld(&bar[XB_XCNT(j)]); sum += c; cnt += (c > 0u) ? 1u : 0u; mine = (j == x) ? c : mine; }
        if (sum == G) break;
        __builtin_amdgcn_s_sleep(1);
        if ((++sp & 255u) == 0u) { if (xb_ld(&bar[XB_TMO])) break; if (sp > XB_SPIN_CAP) { atomicAdd(&bar[XB_TMO], 1u); break; } }
    }
    nloc = mine > 0u ? mine : 1u; nx = cnt > 0u ? cnt : 1u;
}
__device__ __forceinline__ void xcd_barrier(const XcdBarrier& b) {
    asm volatile("s_waitcnt vmcnt(0)" ::: "memory");
    __syncthreads();
    if (threadIdx.x == 0) {
        unsigned* bar = b.bar;
        __builtin_amdgcn_s_waitcnt(0);
        unsigned nloc = b.st[0], nx = b.st[1];
        if (nloc == 0u) { xcd_barrier_complete(bar, b.x, nloc, nx); b.st[0] = nloc; b.st[1] = nx; }
        const unsigned old = xb_add(&bar[XB_XSUB(b.x)], 1u);
        const unsigned gen = old / nloc;
        if (old + 1u == (gen + 1u) * nloc) {
            __builtin_amdgcn_fence(__ATOMIC_RELEASE, "agent");
            asm volatile("s_waitcnt vmcnt(0)" ::: "memory");
            const unsigned og = xb_add(&bar[XB_TOP], 1u);
            const unsigned tg = og / nx;
            if (og + 1u == (tg + 1u) * nx) xb_add(&bar[XB_TOPGEN], 1u);
            else XB_SPIN(xb_ld(&bar[XB_TOPGEN]) == tg, bar);
            __builtin_amdgcn_fence(__ATOMIC_ACQUIRE, "agent");
            xb_add(&bar[XB_XGEN(b.x)], 1u);
            asm volatile("s_waitcnt vmcnt(0)" ::: "memory");
        } else {
            XB_SPIN(xb_ld(&bar[XB_XGEN(b.x)]) == gen, bar);
            __builtin_amdgcn_fence(__ATOMIC_ACQUIRE, "agent");
            asm volatile("s_waitcnt vmcnt(0)" ::: "memory");
        }
    }
    __syncthreads();
}

struct Args { const void* in[18]; float* out; unsigned char* ws; int ph_lo, ph_hi; };
struct Frame {
    LAS unsigned char* lds;
    int tid, lane, wave, vcu, G;
};
typedef const void* cvp_t;
__device__ __forceinline__ const void* arg_in(int i) { const __attribute__((address_space(4))) cvp_t* p = (const __attribute__((address_space(4))) cvp_t*)__builtin_amdgcn_kernarg_segment_ptr(); asm volatile("" : "+s"(p)); return p[i]; }

__device__ __forceinline__ void transpose_item(const float* W, int K, int N, bf16_t* WT, int thresh, int add, const float* gain, LAS float* scr, int item, int lane) {
    const int nblk = N / 32, kb = item / nblk, nb = item % nblk, k0 = 64 * kb, n0 = 32 * nb;
#pragma unroll 8
    for (int i = 0; i < 32; ++i) { const int kk = 2 * i + (lane >> 5); scr[kk * 33 + (lane & 31)] = ((const GAS float*)W)[(size_t)(k0 + kk) * N + n0 + (lane & 31)]; }
    LDS_WAIT(); asm volatile("" ::: "memory");
    const int c = lane & 7;
    float gv[8];
#pragma unroll
    for (int e = 0; e < 8; ++e) gv[e] = gain ? ((const GAS float*)gain)[k0 + 8 * c + e] : 1.0f;
    const int radd = (n0 >= thresh) ? add : 0;
#pragma unroll
    for (int j = 0; j < 4; ++j) { const int n = (lane >> 3) + 8 * j; const LAS float* s = scr + (8 * c) * 33 + n;
        u32x4 o; o.x = cvtpk(s[0 * 33] * gv[0], s[1 * 33] * gv[1]); o.y = cvtpk(s[2 * 33] * gv[2], s[3 * 33] * gv[3]); o.z = cvtpk(s[4 * 33] * gv[4], s[5 * 33] * gv[5]); o.w = cvtpk(s[6 * 33] * gv[6], s[7 * 33] * gv[7]);
        *(GAS u32x4*)(WT + (size_t)(radd + n0 + n) * K + k0 + 8 * c) = o; }
    LDS_WAIT(); asm volatile("" ::: "memory");
}

__device__ __forceinline__ void gemv8_item(const Frame& F, const LAS float* vec, LAS float* red, const float* W, int ldw, int n0, int nvalid, const float* bias, float* out, size_t ostride, int split, int add) {
    const int n = F.tid & 63, kc = F.tid >> 6; const bool ok = (n0 + n) < nvalid;
    const GAS float* w = (const GAS float*)W + (size_t)(kc * 128) * ldw + n0 + n;
    float acc[8];
#pragma unroll
    for (int b = 0; b < 8; ++b) acc[b] = 0.f;
#pragma unroll 4
    for (int k = 0; k < 128; ++k) { const float wv = ok ? w[(size_t)k * ldw] : 0.f;
#pragma unroll
        for (int b = 0; b < 8; ++b) acc[b] += wv * vec[b * DM + kc * 128 + k]; }
#pragma unroll
    for (int b = 0; b < 8; ++b) red[(kc * 8 + b) * 64 + n] = acc[b];
    __syncthreads();
    { const int b = F.tid >> 6; float s = (bias && ok) ? ((const GAS float*)bias)[n0 + n] : 0.f;
#pragma unroll
      for (int k2 = 0; k2 < 8; ++k2) s += red[(k2 * 8 + b) * 64 + n];
      if (ok) ((GAS float*)out)[(size_t)b * ostride + (n0 + n) + ((n0 + n) >= split ? add : 0)] = s; }
    __syncthreads();
}
__device__ __forceinline__ void phase_p0a(const Frame& F, unsigned char* ws) {
    const int gt = blockIdx.x * 512 + F.tid, NT = F.G * 512;
    { const int* pos = (const int*)arg_in(2); float* cosT = (float*)(ws + WS_COS); float* sinT = (float*)(ws + WS_SIN);
      for (int idx = gt; idx < MTOK * 16; idx += NT) { const int t = idx >> 4, i = idx & 15;
          const float inv = 1.0f / __builtin_amdgcn_exp2f((float)(2 * i) * (13.287712379549449f / 32.0f));
          const float ang = (float)((const GAS int*)pos)[t] * inv;
          double rev = (double)ang * 0.15915494309189535; rev -= __builtin_rint(rev);
          const float fr = (float)rev;
          ((GAS float*)cosT)[idx] = __builtin_amdgcn_cosf(fr); ((GAS float*)sinT)[idx] = __builtin_amdgcn_sinf(fr); } }
    { const float* c = (const float*)arg_in(1); LAS float* cact = (LAS float*)F.lds; LAS float* red = (LAS float*)(F.lds + 32768);
      for (int i = F.tid; i < NB * DM; i += 512) { const float v = ((const GAS float*)c)[i]; cact[i] = v / (1.0f + __expf(-v)); }
      __syncthreads();
      for (int item = blockIdx.x; item < DEPTH * 96; item += F.G) { const int l = item / 96, n0 = (item % 96) * 64;
          gemv8_item(F, cact, red, (const float*)arg_in(3) + (size_t)l * DM * (6 * DM), 6 * DM, n0, 6 * DM, (const float*)arg_in(4) + l * (6 * DM), (float*)(ws + WS_MODS) + (size_t)l * NB * (6 * DM), 6 * DM, 1 << 30, 0); } }
}
__device__ __forceinline__ void phase_p0b(const Frame& F, unsigned char* ws) {
    const int gt = blockIdx.x * 512 + F.tid, NT = F.G * 512;
    const float* mods = (const float*)(ws + WS_MODS);
    { LAS float* vec = (LAS float*)F.lds; LAS float* red = (LAS float*)(F.lds + 32768);
      constexpr int I1 = (IN_NAT + 63) / 64, I2 = FF / 64;
      for (int item = blockIdx.x; item < DEPTH * (I1 + I2); item += F.G) {
          const int l = item / (I1 + I2), r = item % (I1 + I2); const bool up = r >= I1; const int part = up ? 3 : 0;
          for (int i = F.tid; i < NB * DM; i += 512) vec[i] = ((const GAS float*)mods)[((size_t)l * NB + (i >> 10)) * (6 * DM) + part * DM + (i & 1023)];
          __syncthreads();
          if (!up) { const int n0 = r * 64; gemv8_item(F, vec, red, (const float*)arg_in(6) + (size_t)l * DM * IN_NAT, IN_NAT, n0, IN_NAT, nullptr, (float*)(ws + WS_SV1) + (size_t)l * NB * NPJ, NPJ, IN_SPLIT, NPJ - IN_NAT); }
          else { const int n0 = (r - I1) * 64; gemv8_item(F, vec, red, (const float*)arg_in(15) + (size_t)l * DM * FF, FF, n0, FF, nullptr, (float*)(ws + WS_SV2) + (size_t)l * NB * FF, FF, 1 << 30, 0); }
      }
      for (int idx = gt; idx < DEPTH * NB * (C_GSB - IN_SPLIT); idx += NT) { const int c = idx % (C_GSB - IN_SPLIT), lb = idx / (C_GSB - IN_SPLIT); ((GAS float*)(ws + WS_SV1))[(size_t)lb * NPJ + IN_SPLIT + c] = 0.f; }
    }
    { LAS float* scr = (LAS float*)(F.lds + F.wave * 16384);
      const int gw = F.vcu * NWAVES + F.wave, NGW = F.G * NWAVES;
      constexpr int I_IN = (DM / 64) * (IN_NAT / 32), I_QUP = (QRANK / 64) * (QFULL / 32), I_KVUP = (KVRANK / 64) * (KVW / 32), I_SB = (512 / 64) * (DM / 32), I_MIX = (DM / 64) * (DM / 32),
                    I_UP = (DM / 64) * (FF / 32), I_DOWN = (FF / 64) * (DM / 32), I_LAYER = I_IN + I_QUP + I_KVUP + 2 * I_SB + I_MIX + I_UP + I_DOWN;
      for (int it = gw; it < DEPTH * I_LAYER; it += NGW) {
          const int l = it / I_LAYER; int r = it % I_LAYER;
          unsigned char* wl = ws + WS_W + (size_t)l * LAYER_W;
          if (r < I_IN) { transpose_item((const float*)arg_in(6) + (size_t)l * DM * IN_NAT, DM, IN_NAT, (bf16_t*)(wl + OW_IN), IN_SPLIT, NPJ - IN_NAT, nullptr, scr, r, F.lane); continue; } r -= I_IN;
          if (r < I_QUP) { transpose_item((const float*)arg_in(8) + (size_t)l * QRANK * QFULL, QRANK, QFULL, (bf16_t*)(wl + OW_QUP), 1 << 30, 0, (const float*)arg_in(7) + l * QRANK, scr, r, F.lane); continue; } r -= I_QUP;
          if (r < I_KVUP) { transpose_item((const float*)arg_in(10) + (size_t)l * KVRANK * KVW, KVRANK, KVW, (bf16_t*)(wl + OW_KVUP), 1 << 30, 0, (const float*)arg_in(9) + l * KVRANK, scr, r, F.lane); continue; } r -= I_KVUP;
          if (r < I_SB) { transpose_item((const float*)arg_in(11) + (size_t)l * 512 * DM, 512, DM, (bf16_t*)(wl + OW_SB), 1 << 30, 0, nullptr, scr, r, F.lane); continue; } r -= I_SB;
          if (r < I_SB) { transpose_item((const float*)arg_in(12) + (size_t)l * 512 * DM, 512, DM, (bf16_t*)(wl + OW_MLA), 1 << 30, 0, nullptr, scr, r, F.lane); continue; } r -= I_SB;
          if (r < I_MIX) { transpose_item((const float*)arg_in(13) + (size_t)l * DM * DM, DM, DM, (bf16_t*)(wl + OW_MIX), 1 << 30, 0, nullptr, scr, r, F.lane); continue; } r -= I_MIX;
          if (r < I_UP) { transpose_item((const float*)arg_in(15) + (size_t)l * DM * FF, DM, FF, (bf16_t*)(wl + OW_UP), 1 << 30, 0, nullptr, scr, r, F.lane); continue; } r -= I_UP;
          transpose_item((const float*)arg_in(16) + (size_t)l * FF * DM, FF, DM, (bf16_t*)(wl + OW_DOWN), 1 << 30, 0, nullptr, scr, r, F.lane);
      }
      constexpr int ZV = (C_GSB - IN_SPLIT) * DM * 2 / 16;
      unsigned zu = 0u; asm volatile("" : "+v"(zu));
      for (int idx = gt; idx < DEPTH * ZV; idx += NT) { const int l = idx / ZV, r = idx % ZV;
          *(GAS u32x4*)(ws + WS_W + (size_t)l * LAYER_W + OW_IN + (size_t)IN_SPLIT * DM * 2 + (size_t)r * 16) = (u32x4){zu, zu, zu, zu}; }
      const float* x = (const float*)arg_in(0); const float* g = (const float*)arg_in(5);
      for (int m = gw; m < MTOK; m += NGW) {
          const GAS f32x4* xr = (const GAS f32x4*)(x + (size_t)m * DM) + F.lane;
          const float* sc = mods + (size_t)(m >> 11) * (6 * DM) + DM;
          float ss = 0.f;
#pragma unroll
          for (int j = 0; j < 4; ++j) { const int c = 4 * F.lane + 256 * j; const f32x4 v = xr[64 * j]; ss += dot4(v);
              st4bf((bf16_t*)(ws + WS_H) + (size_t)m * DM + c, v * (*(const GAS f32x4*)(g + c) * (1.0f + *(const GAS f32x4*)(sc + c)))); }
          ss = wave_sum(ss);
          if (F.lane == 0) *(GAS f32x4*)(ws + WS_XSTAT + (size_t)m * 16) = (f32x4){ss, 0.f, 0.f, 0.f};
      }
    }
}

__device__ __forceinline__ void phase_final(const Frame& F, float* X, const float* g) {
    const int gw = F.vcu * NWAVES + F.wave, NGW = F.G * NWAVES;
    for (int m = gw; m < MTOK; m += NGW) {
        GAS f32x4* xr = (GAS f32x4*)(X + (size_t)m * DM) + F.lane;
        f32x4 v[4]; float ss = 0.f;
#pragma unroll
        for (int j = 0; j < 4; ++j) { v[j] = xr[64 * j]; ss += (v[j][0] * v[j][0] + v[j][1] * v[j][1]) + (v[j][2] * v[j][2] + v[j][3] * v[j][3]); }
        const float rs = 1.0f / sqrtf(wave_sum(ss) * (1.0f / DM) + NORM_EPS);
#pragma unroll
        for (int j = 0; j < 4; ++j) xr[64 * j] = (v[j] * rs) * *(const GAS f32x4*)(g + 4 * F.lane + 256 * j);
    }
}

constexpr int STEPS = 8;
constexpr int N_PHASES = 3 + STEPS * DEPTH;

__global__ void __launch_bounds__(NWAVES * 64, 2) mk_fwd(Args a) {
    extern __shared__ __attribute__((aligned(16))) unsigned char lds_raw[];
    Frame F;
    F.lds = (LAS unsigned char*)lds_raw;
    F.tid = threadIdx.x; F.lane = F.tid & 63; F.wave = __builtin_amdgcn_readfirstlane(F.tid >> 6);
    F.G = gridDim.x; { const int bx = blockIdx.x; F.vcu = (F.G % 8 == 0) ? (bx % 8) * (F.G / 8) + bx / 8 : bx; }
    unsigned char* ws0 = a.ws;
    volatile LAS unsigned* MISC = (volatile LAS unsigned*)(F.lds + MISC_OFF);
    for (int u = F.tid; u < (LDS_BYTES - LDSCTL_OFF) / 4; u += NWAVES * 64) ((LAS unsigned*)(F.lds + LDSCTL_OFF))[u] = 0u;
    __syncthreads();
    const int lo = a.ph_lo, hi = a.ph_hi;
    XcdBarrier bar; bar.bar = (unsigned*)(ws0 + WS_CTL) + CW_BAR; bar.x = 0; bar.st = nullptr;
    if (hi - lo > 1) bar = xcd_barrier_post((unsigned*)(ws0 + WS_CTL) + CW_BAR, MISC + 8);

#define cosT ((const float*)(ws + WS_COS))
#define sinT ((const float*)(ws + WS_SIN))
#define P    ((bf16_t*)(ws + WS_P))
#define U    ((bf16_t*)(ws + WS_P))
#define QF   ((bf16_t*)(ws + WS_QF))
#define KV   ((bf16_t*)(ws + WS_KV))
#define MG   ((bf16_t*)(ws + WS_QF))
#define KPE  ((bf16_t*)(ws + WS_KPE))
#define H    ((bf16_t*)(ws + WS_H))
#define OSB  ((bf16_t*)(ws + WS_H))
#define OMLA ((bf16_t*)(ws + WS_H) + (size_t)MTOK * 512)
#define X    (a.out)
#define wl (ws + WS_W + (size_t)l * LAYER_W)
#define mods_l ((const float*)(ws + WS_MODS) + (size_t)l * NB * (6 * DM))
#define xin ((l == 0) ? (const float*)arg_in(0) : (const float*)X)

#define REFRESH() { unsigned z_ = 0u; asm volatile("" : "+v"(z_)); const int l_ = (int)__builtin_amdgcn_mbcnt_hi(~0u, __builtin_amdgcn_mbcnt_lo(~0u, z_)); F.lane = l_; F.tid = F.wave * 64 + l_; }
#define FRESH() int bx_; unsigned char* ws; { unsigned z_ = 0u; asm volatile("" : "+v"(z_)); const int l_ = (int)__builtin_amdgcn_mbcnt_hi(~0u, __builtin_amdgcn_mbcnt_lo(~0u, z_)); F.lane = l_; F.tid = F.wave * 64 + l_; \
        bx_ = blockIdx.x; asm volatile("" : "+s"(bx_)); ws = ws0; asm volatile("" : "+s"(ws)); { int g_ = gridDim.x; asm volatile("" : "+s"(g_)); F.G = g_; } }
#ifndef DUP_MASK
#define DUP_MASK 0
#endif
    for (int ph = lo; ph < hi; ++ph) {
        const int l = (ph - 2) / STEPS, t = (ph == 0) ? -1 : (ph == 1) ? -3 : (ph == N_PHASES - 1) ? -2 : (ph - 2) % STEPS;
        bool skip_bar = false;
        for (int rep = (DUP_MASK && t >= 0 && ((DUP_MASK >> t) & 1)) ? 0 : 1; rep < 2; ++rep) {
        if (DUP_MASK && rep == 1 && t >= 0 && ((DUP_MASK >> t) & 1)) xcd_barrier(bar);
        if (t == -1) {
            FRESH(); (void)bx_;
            phase_p0a(F, ws);
        } else if (t == -3) {
            FRESH(); (void)bx_;
            phase_p0b(F, ws);
        } else if (t == -2) {
            FRESH(); (void)bx_; (void)ws;
            phase_final(F, X, (const float*)arg_in(17));
#ifdef DBG_STAT
            VM_WAIT(); __syncthreads(); if (F.vcu == 0 && F.tid == 0) X[0] = (float)__hip_atomic_load((unsigned*)(ws0 + WS_CTL) + 100000, __ATOMIC_RELAXED, __HIP_MEMORY_SCOPE_AGENT) * 0.01f;
#endif
        } else if (t == 3) {
            FRESH(); (void)bx_;
            {
                volatile LAS unsigned* qslot = (volatile LAS unsigned*)(F.lds + LDSCTL_OFF + 512);
                unsigned* qctr = (unsigned*)(ws + WS_CTL) + CW_QUEUE + 64 * (l * 2 + rep);
                for (;;) {
                    if (F.tid == 0) qslot[0] = __hip_atomic_fetch_add(qctr, 1u, __ATOMIC_RELAXED, __HIP_MEMORY_SCOPE_AGENT);
                    __syncthreads();
                    const int idx = (int)qslot[0];
                    __syncthreads();
                    if (idx >= 1024) break;
                    const int j = idx & 511, qb = 7 - (j >> 6), bh = j & 63, b = bh >> 3, h = bh & 7;
                    if (idx < 512) attn_unit<true>(F.lds, F.tid, b, qb, QF, QFULL, h * 96, KV, KVW, h * 128, KPE, KV, KVW, h * 128 + 64, OMLA, 512, h * 64);
                    else attn_unit<false>(F.lds, F.tid, b, qb, P, NPJ, C_QSB + h * 64, P, NPJ, C_KSB + h * 64, KPE, P, NPJ, C_VSB + h * 64, OSB, 512, h * 64);
                }
            }
        } else {
            FRESH();
            pg8::Gemm g; pg8::Order S; EpiAll E; int N = DM, crot = 0;
            g.A2 = nullptr; g.Bt2 = nullptr; S.pair = 0;
            E.ws = ws; E.xo = X; E.base = nullptr; E.gate = nullptr; E.gn = nullptr; E.scn = nullptr; E.sv = nullptr; E.part = (LAS float*)(F.lds + LDSCTL_OFF + 1024);
            if (t == 0) {
                g.A = H; g.Bt = (const bf16_t*)(wl + OW_IN); g.lda = DM; g.ldb = DM; g.K = DM; N = NPJ; E.kind = 0; E.sv = (const float*)(ws + WS_SV1) + (size_t)l * NB * NPJ;
            } else if (t == 1) {
                g.A = P + C_QLAT; g.Bt = (const bf16_t*)(wl + OW_QUP); g.lda = NPJ; g.ldb = QRANK; g.K = QRANK; N = QFULL; E.kind = 1; skip_bar = true;
            } else if (t == 2) {
                g.A = P + C_KVLAT; g.Bt = (const bf16_t*)(wl + OW_KVUP); g.lda = NPJ; g.ldb = KVRANK; g.K = KVRANK; N = KVW; E.kind = 2; crot = 192;
            } else if (t == 4) {
                g.A = OSB; g.Bt = (const bf16_t*)(wl + OW_SB); g.A2 = OMLA; g.Bt2 = (const bf16_t*)(wl + OW_MLA); g.lda = 512; g.ldb = 512; g.K = 512; S.pair = 1; E.kind = 3;
            } else if (t == 6) {
                g.A = H; g.Bt = (const bf16_t*)(wl + OW_UP); g.lda = DM; g.ldb = DM; g.K = DM; N = FF; E.kind = 5; E.sv = (const float*)(ws + WS_SV2) + (size_t)l * NB * FF;
            } else {
                const bool isF = (t == 7);
                g.A = isF ? U : MG; g.Bt = (const bf16_t*)(wl + (isF ? OW_DOWN : OW_MIX)); g.lda = isF ? FF : DM; g.ldb = g.lda; g.K = g.lda;
                E.kind = 4; E.base = isF ? (const float*)X : xin; E.gate = mods_l + (isF ? 5 : 2) * DM;
                const int ln = isF ? ((l + 1 < DEPTH) ? l + 1 : l) : l;
                E.gn = (const float*)arg_in(isF ? 5 : 14) + ln * DM; E.scn = (const float*)(ws + WS_MODS) + (size_t)ln * NB * (6 * DM) + (isF ? 1 : 4) * DM;
            }
            S.s.init(MTOK, N, F.G, (int)(((unsigned)bx_ + (unsigned)crot) % (unsigned)F.G));
            pg8::gemm_phase<EpiAll, pg8::Order, true>(F.lds, F.tid, g, S, E);
        }
        }
        if (ph + 1 < hi && !skip_bar) xcd_barrier(bar);
    }
}

extern "C" void kernel_launch(void* const* d_in, const int* in_sizes, int n_in, void* d_out, int out_size, void* d_ws, size_t ws_size, hipStream_t stream) {
    static int grid = 0;
    if (grid == 0) {
        if (n_in != 18 || in_sizes[0] != MTOK * DM || out_size != MTOK * DM || ws_size < WS_END) {
            fprintf(stderr, "kernel_launch: unexpected shapes (n_in %d, in0 %d, out %d, ws %zu); nothing launched\n", n_in, n_in > 0 ? in_sizes[0] : -1, out_size, ws_size); grid = -1; return; }
        int dev = 0, cus = 0, per_cu = 0;
        if (hipGetDevice(&dev) != hipSuccess || hipDeviceGetAttribute(&cus, hipDeviceAttributeMultiprocessorCount, dev) != hipSuccess) { grid = -1; return; }
        if (hipFuncSetAttribute((const void*)mk_fwd, hipFuncAttributeMaxDynamicSharedMemorySize, LDS_BYTES) != hipSuccess) { fprintf(stderr, "kernel_launch: hipFuncSetAttribute failed\n"); grid = -1; return; }
        if (hipOccupancyMaxActiveBlocksPerMultiprocessor(&per_cu, (const void*)mk_fwd, NWAVES * 64, LDS_BYTES) != hipSuccess || per_cu < 1) {
            fprintf(stderr, "kernel_launch: occupancy query reports %d workgroups per CU; nothing launched\n", per_cu); (void)hipGetLastError(); grid = -1; return; }
        grid = cus;
    }
    if (grid < 0) return;
    (void)hipMemsetAsync((char*)d_ws + WS_CTL, 0, CTL_ZERO_BYTES, stream);
    Args a{};
    for (int i = 0; i < 18; ++i) a.in[i] = d_in[i];
    a.out = (float*)d_out; a.ws = (unsigned char*)d_ws;
#if MK_N_LAUNCHES == 1
    a.ph_lo = 0; a.ph_hi = N_PHASES;
    void* kargs[] = {&a};
    hipError_t e = hipLaunchCooperativeKernel((const void*)mk_fwd, dim3(grid), dim3(NWAVES * 64), kargs, LDS_BYTES, stream);
    if (e != hipSuccess) fprintf(stderr, "kernel_launch: cooperative launch failed: %s (grid %d)\n", hipGetErrorString(e), grid);
#else
    for (int ph = 0; ph < N_PHASES; ++ph) {
        a.ph_lo = ph; a.ph_hi = ph + 1;
        hipLaunchKernelGGL(mk_fwd, dim3(grid), dim3(NWAVES * 64), LDS_BYTES, stream, a);
    }
#endif
}
```

```cpp
#include <hip/hip_runtime.h>
#include <cstdio>
#include <cstdint>

#ifndef MK_N_LAUNCHES
#define MK_N_LAUNCHES 1
#endif

#define LAS __attribute__((address_space(3)))
#define GAS __attribute__((address_space(1)))
typedef unsigned short bf16_t;
typedef short bf16x8 __attribute__((ext_vector_type(8)));
typedef short s16x4 __attribute__((ext_vector_type(4)));
typedef float f32x2 __attribute__((ext_vector_type(2)));
typedef float f32x4 __attribute__((ext_vector_type(4)));
typedef float f32x16 __attribute__((ext_vector_type(16)));
typedef unsigned u32x2 __attribute__((ext_vector_type(2)));
typedef unsigned u32x4 __attribute__((ext_vector_type(4)));
typedef __bf16 bf16x2_t __attribute__((ext_vector_type(2)));

constexpr int DM = 1024, NB = 8, SEQ = 2048, MTOK = NB * SEQ, DEPTH = 4, FF = 4096;
constexpr int NPJ = 4352;
constexpr int C_QSB = 0, C_KSB = 512, C_VSB = 1024, C_QLAT = 1536, C_KVLAT = 1920, C_KROPE = 2176, C_GSB = 2304, C_GMLA = 3328;
constexpr int IN_NAT = 4256, IN_SPLIT = 2208;
constexpr int QRANK = 384, KVRANK = 256, QFULL = 768, KVW = 1024;
constexpr float NORM_EPS = 1e-6f;
constexpr float LOG2E = 1.4426950408889634f;
constexpr float C2SB = 0.125f * LOG2E;
constexpr float C2MLA = 0.10206207261596577f * LOG2E;

constexpr size_t MiB = 1u << 20;
constexpr size_t WS_CTL = 0, CTL_ZERO_BYTES = 1 * MiB;
constexpr size_t WS_COS = 1 * MiB, WS_SIN = 2 * MiB;
constexpr size_t WS_MODS = 3 * MiB;
constexpr size_t WS_XSTAT = 3 * MiB + 786432;
constexpr size_t WS_W = 4 * MiB;
constexpr size_t OW_IN = 0, OW_QUP = OW_IN + (size_t)NPJ * DM * 2, OW_KVUP = OW_QUP + (size_t)QFULL * QRANK * 2, OW_SB = OW_KVUP + (size_t)KVW * KVRANK * 2,
                 OW_MLA = OW_SB + (size_t)DM * 512 * 2, OW_MIX = OW_MLA + (size_t)DM * 512 * 2, OW_UP = OW_MIX + (size_t)DM * DM * 2, OW_DOWN = OW_UP + (size_t)FF * DM * 2,
                 LAYER_W = OW_DOWN + (size_t)DM * FF * 2;
constexpr size_t WS_P = 123 * MiB;
constexpr size_t WS_QF = 259 * MiB;
constexpr size_t WS_KV = 283 * MiB;
constexpr size_t WS_LSTAT = 315 * MiB;
constexpr size_t WS_SV1 = 317 * MiB;
constexpr size_t WS_SV2 = 318 * MiB;
constexpr size_t WS_KPE = 335 * MiB;
constexpr size_t WS_H = 336 * MiB;
constexpr size_t WS_END = 368 * MiB;
static_assert(WS_W + DEPTH * LAYER_W <= WS_P, "weights fit");

constexpr int RING_BYTES = 131072;
constexpr int LDSCTL_OFF = RING_BYTES, MISC_OFF = LDSCTL_OFF + 320;
constexpr int LDS_BYTES = 147456;
constexpr int NWAVES = 8;

#ifndef USE_F16
#define USE_F16 0
#endif
typedef _Float16 half2_t __attribute__((ext_vector_type(2)));
typedef _Float16 half8_t __attribute__((ext_vector_type(8)));
#if USE_F16
__device__ __forceinline__ unsigned cvtpk(float lo, float hi) { f32x2 v = {lo, hi}; half2_t b = __builtin_convertvector(v, half2_t); return __builtin_bit_cast(unsigned, b); }
__device__ __forceinline__ float bf2f(unsigned short h) { return (float)__builtin_bit_cast(_Float16, h); }
__device__ __forceinline__ float up_lo(unsigned w) { return (float)__builtin_bit_cast(half2_t, w)[0]; }
__device__ __forceinline__ float up_hi(unsigned w) { return (float)__builtin_bit_cast(half2_t, w)[1]; }
#define MFMA16(a, b, c) __builtin_amdgcn_mfma_f32_16x16x32_f16(__builtin_bit_cast(half8_t, a), __builtin_bit_cast(half8_t, b), c, 0, 0, 0)
#define MFMA32(a, b, c) __builtin_amdgcn_mfma_f32_32x32x16_f16(__builtin_bit_cast(half8_t, a), __builtin_bit_cast(half8_t, b), c, 0, 0, 0)
#else
__device__ __forceinline__ unsigned cvtpk(float lo, float hi) { f32x2 v = {lo, hi}; bf16x2_t b = __builtin_convertvector(v, bf16x2_t); return __builtin_bit_cast(unsigned, b); }
__device__ __forceinline__ float bf2f(unsigned short h) { return __builtin_bit_cast(float, (unsigned)h << 16); }
__device__ __forceinline__ float up_lo(unsigned w) { return __builtin_bit_cast(float, w << 16); }
__device__ __forceinline__ float up_hi(unsigned w) { return __builtin_bit_cast(float, w & 0xffff0000u); }
#define MFMA16(a, b, c) __builtin_amdgcn_mfma_f32_16x16x32_bf16(a, b, c, 0, 0, 0)
#define MFMA32(a, b, c) __builtin_amdgcn_mfma_f32_32x32x16_bf16(a, b, c, 0, 0, 0)
#endif
__device__ __forceinline__ void st4bf(bf16_t* p, f32x4 v) { u32x2 w; w.x = cvtpk(v[0], v[1]); w.y = cvtpk(v[2], v[3]); *(GAS u32x2*)p = w; }
__device__ __forceinline__ f32x4 bf4(u32x2 w) { f32x4 r; r[0] = up_lo(w.x); r[1] = up_hi(w.x); r[2] = up_lo(w.y); r[3] = up_hi(w.y); return r; }
__device__ __forceinline__ f32x4 ld4bf(const bf16_t* p) { return bf4(*(const GAS u32x2*)p); }
#define swz_xor(v, pat) __builtin_bit_cast(float, __builtin_amdgcn_ds_swizzle(__builtin_bit_cast(int, (float)(v)), (pat)))
__device__ __forceinline__ void swap32(float& a, float& b) { asm volatile("s_nop 1\n\tv_permlane32_swap_b32 %0, %1" : "+v"(a), "+v"(b)); }
__device__ __forceinline__ float sum_halves(float v) { float a = v, b = v; swap32(a, b); return a + b; }
__device__ __forceinline__ float max_halves(float v) { float a = v, b = v; swap32(a, b); return fmaxf(a, b); }
__device__ __forceinline__ float other_half(float v, int hi) { float a = v, b = v; swap32(a, b); return hi ? a : b; }
#ifndef DBG_SHFL_SUM
#define DBG_SHFL_SUM 0
#endif
__device__ __forceinline__ float wave_sum(float v) {
#if DBG_SHFL_SUM
#pragma unroll
    for (int o = 1; o < 64; o <<= 1) v += __shfl_xor(v, o);
    return v;
#else
    v += swz_xor(v, (1 << 10) | 0x1f); v += swz_xor(v, (2 << 10) | 0x1f); v += swz_xor(v, (4 << 10) | 0x1f); v += swz_xor(v, (8 << 10) | 0x1f); v += swz_xor(v, (16 << 10) | 0x1f);
    return sum_halves(v);
#endif
}
#define LDS_WAIT() asm volatile("s_waitcnt lgkmcnt(0)" ::: "memory")
#define VM_WAIT() asm volatile("s_waitcnt vmcnt(0)" ::: "memory")

namespace pg8 {
constexpr int BM = 256, BK = 64, HALF = 128, HTB = HALF * BK * 2, STAGE_BYTES = 8 * HTB, NXCD = 8, WGM = 8;
__host__ __device__ __forceinline__ int lds_byte(int r, int c) { const int st = (r >> 4) * 2 + (c >> 5), rr = r & 15, cc = c & 31, ob = rr * 64 + cc * 2; return st * 1024 + (ob ^ (((ob >> 9) & 1) << 5)); }
__host__ __device__ __forceinline__ void stage_rc(int b, int& R, int& C) { const int st = b / 1024, sb = b % 1024, swz = sb ^ (((sb >> 9) & 1) << 5); R = (st >> 1) * 16 + swz / 64; C = (st & 1) * 32 + (swz % 64) / 2; }

struct Unit { int pm, pn, z; };
struct Gemm { const bf16_t* A; const bf16_t* Bt; const bf16_t* A2; const bf16_t* Bt2; int lda, ldb, K; };

struct StaticOrder {
    int nM, nN, nwg, G, c;
    __host__ __device__ void init(int M, int N, int G_, int c_) { nM = M / BM; nN = N / BM; nwg = nM * nN; G = G_; c = c_; }
    __host__ __device__ bool next(int i, Unit& u) const {
        const long L = (long)i * G + c; if (L >= nwg) return false;
        int wgid = (int)L; { const int q = nwg / NXCD, r = nwg % NXCD, xcd = wgid % NXCD, off = wgid / NXCD; wgid = (xcd < r ? xcd * (q + 1) : r * (q + 1) + (xcd - r) * q) + off; }
        const int nig = WGM * nN, gid = wgid / nig, fm = gid * WGM, gsz = (nM - fm) < WGM ? (nM - fm) : WGM;
        u.pm = fm + ((wgid % nig) % gsz); u.pn = (wgid % nig) / gsz; u.z = 0; return true;
    }
};
struct Order {
    StaticOrder s; int pair;
    __host__ __device__ bool next(int i, Unit& u) const { if (!s.next(pair ? (i >> 1) : i, u)) return false; u.z = pair ? (i & 1) : 0; return true; }
};

template <class F> struct Epi {
    F f;
    __device__ __forceinline__ void operator()(const f32x4 (&acc)[2][2][4][2], const Unit& u, int wr, int wc, int fr, int fq) const {
        { unsigned z_ = 0u; asm volatile("" : "+v"(z_)); const int l_ = (int)__builtin_amdgcn_mbcnt_hi(~0u, __builtin_amdgcn_mbcnt_lo(~0u, z_)); fr = l_ & 15; fq = l_ >> 4; }
        const int row0 = u.pm * BM + wr * 64 + fr;
        typename F::Row rw[8];
#pragma unroll
        for (int it = 0; it < 8; ++it) rw[it] = f.loadrow(u, row0 + (it >> 2) * HALF + (it & 3) * 16);
#pragma unroll
        for (int bj = 0; bj < 2; ++bj) {
            const int col = u.pn * BM + bj * HALF + wc * 32 + 4 * fq;
            const typename F::Ctx cx = f.prep(u, col);
            constexpr int PD = F::PD;
            typename F::Ld q[8];
#pragma unroll
            for (int it = 0; it < PD; ++it) q[it] = f.load(cx, u, row0 + (it >> 2) * HALF + (it & 3) * 16, col);
#pragma unroll
            for (int it = 0; it < 8; ++it) {
                const int ai = it >> 2, m = it & 3, row = row0 + ai * HALF + m * 16;
                if (it + PD < 8) q[it + PD] = f.load(cx, u, row0 + ((it + PD) >> 2) * HALF + ((it + PD) & 3) * 16, col);
                f.finish(cx, u, row, col, rw[it], q[it], acc[ai][bj][m][0], acc[ai][bj][m][1], fq);
                if (PD > 0) asm volatile("" ::: "memory");
            }
        }
        f.post(u, wr * 4 + wc, fr + 16 * fq);
    }
};

template <class EpiT, class Sched, bool ALIGN_EPI>
__device__ __forceinline__ void gemm_phase(LAS unsigned char* lds, int tid, const Gemm g, const Sched& S, const EpiT& E) {
    asm volatile("" : "+v"(tid));
    const int wid = __builtin_amdgcn_readfirstlane(tid >> 6), lane = tid & 63, wr = wid >> 2, wc = wid & 3, fr = lane & 15, fq = lane >> 4;
    const int K = g.K, nt = K / BK;
    unsigned voffA[2], voffB[2];
#pragma unroll
    for (int i = 0; i < 2; ++i) { int R, C; stage_rc(tid * 16 + i * 8192, R, C);
        voffA[i] = (unsigned)(R * g.lda + C) * 2u; voffB[i] = (unsigned)(R * g.ldb + C) * 2u; }
    const size_t kstep = (size_t)(BK * 2);
    const size_t hstepA = (size_t)HALF * g.lda * 2, hstepB = (size_t)HALF * g.ldb * 2;
    const size_t tstepA = 2 * hstepA, tstepB = 2 * hstepB;
    const unsigned ldsw = (unsigned)wid * 1024u;
    const int aoff = lds_byte(wr * 64 + fr, fq * 8), boff = lds_byte(wc * 32 + fr, fq * 8);
#define PG8_SA(b, h) (((b) * 2 + (h)) * HTB)
#define PG8_SB(b, h) ((4 + (b) * 2 + (h)) * HTB)
#define PG8_STAGE(bufoff, gbase, voff) do { _Pragma("unroll") for (int _i = 0; _i < 2; ++_i) \
        __builtin_amdgcn_global_load_lds((const unsigned*)((const char*)(gbase) + (voff)[_i]), (LAS unsigned*)(lds + (bufoff) + ldsw + _i * 8192), 16, 0, 0); } while (0)
#define PG8_LDA(dst, b, h) do { _Pragma("unroll") for (int m = 0; m < 4; ++m) _Pragma("unroll") for (int k = 0; k < 2; ++k) dst[m][k] = *(const LAS bf16x8*)(lds + PG8_SA(b, h) + aoff + m * 2048 + k * 1024); } while (0)
#define PG8_LDB(dst, b, h) do { _Pragma("unroll") for (int n = 0; n < 2; ++n) _Pragma("unroll") for (int k = 0; k < 2; ++k) dst[n][k] = *(const LAS bf16x8*)(lds + PG8_SB(b, h) + boff + n * 2048 + k * 1024); } while (0)
#define PG8_MMA(ai, bj, At, Bt) do { __builtin_amdgcn_s_setprio(1); _Pragma("unroll") for (int m = 0; m < 4; ++m) _Pragma("unroll") for (int n = 0; n < 2; ++n) _Pragma("unroll") for (int k = 0; k < 2; ++k) \
        acc[ai][bj][m][n] = MFMA16(Bt[n][k], At[m][k], acc[ai][bj][m][n]); __builtin_amdgcn_s_setprio(0); } while (0)
#define PG8_WAIT_V(n) asm volatile("s_waitcnt vmcnt(" #n ")" ::: "memory")
#define PG8_WAIT_L(n) asm volatile("s_waitcnt lgkmcnt(" #n ")" ::: "memory")
#define PG8_BAR __builtin_amdgcn_s_barrier()
#define PG8_SCHED __builtin_amdgcn_sched_barrier(0)
    Unit cur, nxt; int ui = 0;
    if (!S.next(0, cur)) return;
    f32x4 acc[2][2][4][2];
    { float zf = 0.f; asm volatile("" : "+v"(zf));
#pragma unroll
    for (int a = 0; a < 2; ++a)
#pragma unroll
        for (int b = 0; b < 2; ++b)
#pragma unroll
            for (int m = 0; m < 4; ++m)
#pragma unroll
                for (int n = 0; n < 2; ++n) acc[a][b][m][n] = (f32x4){zf, zf, zf, zf}; }
    bf16x8 At[4][2], B0[2][2], B1[2][2];
    const char* cA = (const char*)(cur.z ? g.A2 : g.A) + (size_t)cur.pm * tstepA; const char* cB = (const char*)(cur.z ? g.Bt2 : g.Bt) + (size_t)cur.pn * tstepB;
    PG8_STAGE(PG8_SB(0, 0), cB, voffB); PG8_STAGE(PG8_SB(0, 1), cB + hstepB, voffB); PG8_STAGE(PG8_SA(0, 0), cA, voffA); PG8_STAGE(PG8_SA(0, 1), cA + hstepA, voffA);
    if (wr == 1) PG8_BAR;
    PG8_WAIT_V(2); PG8_BAR;
    PG8_STAGE(PG8_SB(1, 0), cB + kstep, voffB); PG8_STAGE(PG8_SA(1, 0), cA + kstep, voffA); PG8_STAGE(PG8_SB(1, 1), cB + hstepB + kstep, voffB);
    PG8_WAIT_V(6); PG8_BAR;
    for (;;) {
        const bool has_next = S.next(ui + 1, nxt);
        const char* nA = has_next ? (const char*)(nxt.z ? g.A2 : g.A) + (size_t)nxt.pm * tstepA : cA; const char* nB = has_next ? (const char*)(nxt.z ? g.Bt2 : g.Bt) + (size_t)nxt.pn * tstepB : cB;
        for (int t = 0; t < nt; t += 2) {
            const bool last = (t == nt - 2);
            const char* a1 = cA + (size_t)(t + 1) * kstep;
            const char* a2 = last ? nA : cA + (size_t)(t + 2) * kstep; const char* b2 = last ? nB : cB + (size_t)(t + 2) * kstep;
            const char* a3 = a2 + kstep; const char* b3 = b2 + kstep;
            PG8_LDB(B0, 0, 0); PG8_LDB(B1, 0, 1); PG8_SCHED; PG8_LDA(At, 0, 0); PG8_STAGE(PG8_SA(1, 1), a1 + hstepA, voffA);
            PG8_WAIT_V(8); PG8_WAIT_L(0); PG8_BAR; PG8_MMA(0, 0, At, B0); PG8_MMA(0, 1, At, B1); PG8_BAR; PG8_SCHED;
            PG8_LDA(At, 0, 1); PG8_STAGE(PG8_SB(0, 0), b2, voffB); PG8_STAGE(PG8_SB(0, 1), b2 + hstepB, voffB); PG8_STAGE(PG8_SA(0, 0), a2, voffA);
            PG8_WAIT_V(8); PG8_WAIT_L(0); PG8_BAR; PG8_MMA(1, 0, At, B0); PG8_MMA(1, 1, At, B1); PG8_BAR; PG8_SCHED;
            PG8_LDB(B0, 1, 0); PG8_LDB(B1, 1, 1); PG8_SCHED; PG8_LDA(At, 1, 0); PG8_STAGE(PG8_SA(0, 1), a2 + hstepA, voffA);
            PG8_WAIT_V(8); PG8_WAIT_L(0); PG8_BAR; PG8_MMA(0, 0, At, B0); PG8_MMA(0, 1, At, B1); PG8_BAR; PG8_SCHED;
            PG8_LDA(At, 1, 1); PG8_STAGE(PG8_SB(1, 0), b3, voffB); PG8_STAGE(PG8_SB(1, 1), b3 + hstepB, voffB); PG8_STAGE(PG8_SA(1, 0), a3, voffA);
            PG8_WAIT_V(8); PG8_WAIT_L(0); PG8_BAR; PG8_MMA(1, 0, At, B0); PG8_MMA(1, 1, At, B1); PG8_BAR; PG8_SCHED;
        }
        if constexpr (ALIGN_EPI) { if (wr == 0) PG8_BAR; }
        E(acc, cur, wr, wc, fr, fq);
        if (!has_next) break;
        { float zf = 0.f; asm volatile("" : "+v"(zf));
#pragma unroll
        for (int a = 0; a < 2; ++a)
#pragma unroll
            for (int b = 0; b < 2; ++b)
#pragma unroll
                for (int m = 0; m < 4; ++m)
#pragma unroll
                    for (int n = 0; n < 2; ++n) acc[a][b][m][n] = (f32x4){zf, zf, zf, zf}; }
        cur = nxt; cA = nA; cB = nB; ++ui;
        if constexpr (ALIGN_EPI) { if (wr == 1) PG8_BAR; }
    }
    PG8_WAIT_V(0);
    if constexpr (!ALIGN_EPI) { if (wr == 0) PG8_BAR; }
    PG8_BAR;
#undef PG8_SA
#undef PG8_SB
#undef PG8_STAGE
#undef PG8_LDA
#undef PG8_LDB
#undef PG8_MMA
#undef PG8_WAIT_V
#undef PG8_WAIT_L
#undef PG8_BAR
#undef PG8_SCHED
}
}

__device__ __forceinline__ float sum_fq(float v) { v += swz_xor(v, (16 << 10) | 0x1f); return sum_halves(v); }
__device__ __forceinline__ float dot4(f32x4 a) { return (a[0] * a[0] + a[1] * a[1]) + (a[2] * a[2] + a[3] * a[3]); }
struct LdNone { int d; };
struct F_ProjA {
    bf16_t* P; const float* xstat; const float* sv; float* lstat; bf16_t* kpe; const float* cosT; const float* sinT;
    struct Ctx { float sc; f32x4 s0, s1; int grp; }; struct Ld { f32x4 ct, sn; }; struct Row { float rs; }; static constexpr int PD = 1;
    __device__ __forceinline__ Row loadrow(const pg8::Unit&, int row) const { const f32x4 xs = *(const GAS f32x4*)(xstat + (size_t)row * 4); Row r; r.rs = 1.0f / sqrtf(((xs[0] + xs[1]) + (xs[2] + xs[3])) * (1.0f / DM) + NORM_EPS); return r; }
    __device__ __forceinline__ Ctx prep(const pg8::Unit& u, int col) const { Ctx c; c.sc = (u.pn < 2) ? C2SB : 1.0f; const float* sp = sv + (size_t)(u.pm >> 3) * NPJ + col;
        c.s0 = *(const GAS f32x4*)sp; c.s1 = *(const GAS f32x4*)(sp + 16); c.grp = col >> 5; return c; }
    __device__ __forceinline__ Ld load(const Ctx& c, const pg8::Unit&, int row, int col) const { Ld l; l.ct = c.s0; l.sn = c.s0;
        if (c.grp == (C_KROPE >> 5)) { l.ct = *(const GAS f32x4*)(cosT + (size_t)row * 16 + (col & 15)); l.sn = *(const GAS f32x4*)(sinT + (size_t)row * 16 + (col & 15)); } return l; }
    __device__ __forceinline__ void finish(const Ctx& c, const pg8::Unit&, int row, int col, const Row& rw, const Ld& l, f32x4 v0, f32x4 v1, int fq) const {
        v0 = v0 * rw.rs + c.s0; v1 = v1 * rw.rs + c.s1;
        if (c.grp >= (C_QLAT >> 5) && c.grp < (C_KROPE >> 5)) {
            const float ss = sum_fq(dot4(v0) + dot4(v1));
            if (fq == 0) ((GAS float*)lstat)[(size_t)row * 24 + (c.grp - (C_QLAT >> 5))] = ss;
        }
        if (c.grp == (C_KROPE >> 5)) {
            const f32x4 a = v0 * l.ct - v1 * l.sn, b = v1 * l.ct + v0 * l.sn;
            bf16_t* ko = kpe + (size_t)row * 32 + (col & 15); st4bf(ko, a); st4bf(ko + 16, b);
        }
        bf16_t* o = P + (size_t)row * NPJ + col; st4bf(o, v0 * c.sc); st4bf(o + 16, v1 * c.sc); }
    __device__ __forceinline__ void post(const pg8::Unit&, int, int) const {}
};
struct F_Qup {
    bf16_t* Q; const float* cosT; const float* sinT; const float* lstat;
    struct Ctx { int rope; }; struct Ld { f32x4 a, b, c, ct, st; }; typedef LdNone Row; static constexpr int PD = 1;
    __device__ __forceinline__ Row loadrow(const pg8::Unit&, int) const { Row r; r.d = 0; return r; }
    __device__ __forceinline__ Ctx prep(const pg8::Unit&, int col) const { Ctx c; c.rope = (((col >> 5) % 3) == 2) ? 1 : 0; return c; }
    __device__ __forceinline__ Ld load(const Ctx&, const pg8::Unit&, int row, int col) const { Ld l; const int i0 = col & 15; const float* ls = lstat + (size_t)row * 24;
        l.a = *(const GAS f32x4*)ls; l.b = *(const GAS f32x4*)(ls + 4); l.c = *(const GAS f32x4*)(ls + 8);
        l.ct = *(const GAS f32x4*)(cosT + (size_t)row * 16 + i0); l.st = *(const GAS f32x4*)(sinT + (size_t)row * 16 + i0); return l; }
    __device__ __forceinline__ void finish(const Ctx& c, const pg8::Unit&, int row, int col, const Row&, const Ld& l, f32x4 v0, f32x4 v1, int) const {
        const f32x4 t = l.a + l.b + l.c; const float rs = 1.0f / sqrtf(((t[0] + t[1]) + (t[2] + t[3])) * (1.0f / QRANK) + NORM_EPS);
        v0 = v0 * rs; v1 = v1 * rs;
        if (c.rope) { const f32x4 a = v0 * l.ct - v1 * l.st, b = v1 * l.ct + v0 * l.st; v0 = a; v1 = b; }
        bf16_t* o = Q + (size_t)row * QFULL + col; st4bf(o, v0 * C2MLA); st4bf(o + 16, v1 * C2MLA); }
    __device__ __forceinline__ void post(const pg8::Unit&, int, int) const {}
};
struct F_Kvup {
    bf16_t* KV; const float* lstat;
    struct Ctx { int d; }; struct Ld { f32x4 a, b; }; typedef LdNone Row; static constexpr int PD = 1;
    __device__ __forceinline__ Row loadrow(const pg8::Unit&, int) const { Row r; r.d = 0; return r; }
    __device__ __forceinline__ Ctx prep(const pg8::Unit&, int) const { Ctx c; c.d = 0; return c; }
    __device__ __forceinline__ Ld load(const Ctx&, const pg8::Unit&, int row, int) const { Ld l; const float* ls = lstat + (size_t)row * 24 + 12; l.a = *(const GAS f32x4*)ls; l.b = *(const GAS f32x4*)(ls + 4); return l; }
    __device__ __forceinline__ void finish(const Ctx&, const pg8::Unit&, int row, int col, const Row&, const Ld& l, f32x4 v0, f32x4 v1, int) const {
        const f32x4 t = l.a + l.b; const float rs = 1.0f / sqrtf(((t[0] + t[1]) + (t[2] + t[3])) * (1.0f / KVRANK) + NORM_EPS);
        bf16_t* o = KV + (size_t)row * KVW + col; st4bf(o, v0 * rs); st4bf(o + 16, v1 * rs); }
    __device__ __forceinline__ void post(const pg8::Unit&, int, int) const {}
};
__device__ __forceinline__ f32x4 sigmoid4(f32x4 g) { f32x4 r;
#pragma unroll
    for (int i = 0; i < 4; ++i) r[i] = __builtin_amdgcn_rcpf(1.0f + __builtin_amdgcn_exp2f(-LOG2E * g[i]));
    return r; }
struct F_Gate {
    const bf16_t* P; bf16_t* Mg;
    struct Ctx { int goff; }; struct Ld { u32x2 g0, g1, m0, m1; }; typedef LdNone Row; static constexpr int PD = 2;
    __device__ __forceinline__ Row loadrow(const pg8::Unit&, int) const { Row r; r.d = 0; return r; }
    __device__ __forceinline__ Ctx prep(const pg8::Unit& u, int) const { Ctx c; c.goff = u.z ? C_GMLA : C_GSB; return c; }
    __device__ __forceinline__ Ld load(const Ctx& c, const pg8::Unit& u, int row, int col) const { Ld l; const bf16_t* gp = P + (size_t)row * NPJ + c.goff + col;
        l.g0 = *(const GAS u32x2*)gp; l.g1 = *(const GAS u32x2*)(gp + 16); l.m0 = l.g0; l.m1 = l.g1;
        if (u.z) { const bf16_t* o = Mg + (size_t)row * DM + col; l.m0 = *(const GAS u32x2*)o; l.m1 = *(const GAS u32x2*)(o + 16); } return l; }
    __device__ __forceinline__ void finish(const Ctx&, const pg8::Unit& u, int row, int col, const Row&, const Ld& l, f32x4 v0, f32x4 v1, int) const {
        bf16_t* o = Mg + (size_t)row * DM + col;
        f32x4 r0 = sigmoid4(bf4(l.g0)) * v0, r1 = sigmoid4(bf4(l.g1)) * v1;
        if (u.z) { r0 += bf4(l.m0); r1 += bf4(l.m1); }
        st4bf(o, r0); st4bf(o + 16, r1); }
    __device__ __forceinline__ void post(const pg8::Unit&, int, int) const {}
};
struct F_Resid {
    const float* base; float* X; const float* gate; const float* gn; const float* scn; bf16_t* XG; float* xstat; LAS float* part;
    struct Ctx { f32x4 g0, g1, m0, m1; int slot; }; struct Ld { f32x4 b0, b1; }; typedef LdNone Row; static constexpr int PD = 2;
    __device__ __forceinline__ Row loadrow(const pg8::Unit&, int) const { Row r; r.d = 0; return r; }
    __device__ __forceinline__ Ctx prep(const pg8::Unit& u, int col) const { Ctx c; const size_t bo = (size_t)(u.pm >> 3) * (6 * DM) + col; const float* gp = gate + bo; c.g0 = *(const GAS f32x4*)gp; c.g1 = *(const GAS f32x4*)(gp + 16);
        const float* sp = scn + bo; c.m0 = *(const GAS f32x4*)(gn + col) * (1.0f + *(const GAS f32x4*)sp); c.m1 = *(const GAS f32x4*)(gn + col + 16) * (1.0f + *(const GAS f32x4*)(sp + 16));
        c.slot = (col >> 5) & 7; return c; }
    __device__ __forceinline__ Ld load(const Ctx&, const pg8::Unit&, int row, int col) const { Ld l; const size_t off = (size_t)row * DM + col; l.b0 = *(const GAS f32x4*)(base + off); l.b1 = *(const GAS f32x4*)(base + off + 16); return l; }
    __device__ __forceinline__ void finish(const Ctx& c, const pg8::Unit&, int row, int col, const Row&, const Ld& l, f32x4 v0, f32x4 v1, int fq) const {
        const size_t off = (size_t)row * DM + col;
        const f32x4 x0 = l.b0 + c.g0 * v0, x1 = l.b1 + c.g1 * v1;
        *(GAS f32x4*)(X + off) = x0; *(GAS f32x4*)(X + off + 16) = x1;
        st4bf(XG + off, x0 * c.m0); st4bf(XG + off + 16, x1 * c.m1);
        const float ss = sum_fq(dot4(x0) + dot4(x1));
        if (fq == 0) part[(row & 255) * 8 + c.slot] = ss; }
    __device__ __forceinline__ void post(const pg8::Unit& u, int wave, int lane) const {
        asm volatile("s_waitcnt lgkmcnt(0)" ::: "memory"); __builtin_amdgcn_s_barrier(); asm volatile("" ::: "memory");
        if (wave < 4) { const int r = wave * 64 + lane; const LAS float* p = part + r * 8;
            ((GAS float*)xstat)[(size_t)(u.pm * 256 + r) * 4 + u.pn] = ((p[0] + p[1]) + (p[2] + p[3])) + ((p[4] + p[5]) + (p[6] + p[7])); }
        asm volatile("s_waitcnt lgkmcnt(0)" ::: "memory"); __builtin_amdgcn_s_barrier(); asm volatile("" ::: "memory");
    }
};
struct F_Sqrelu {
    bf16_t* U; const float* xstat; const float* sv;
    struct Ctx { f32x4 s0, s1; }; typedef LdNone Ld; struct Row { float rs; }; static constexpr int PD = 0;
    __device__ __forceinline__ Row loadrow(const pg8::Unit&, int row) const { const f32x4 xs = *(const GAS f32x4*)(xstat + (size_t)row * 4); Row r; r.rs = 1.0f / sqrtf(((xs[0] + xs[1]) + (xs[2] + xs[3])) * (1.0f / DM) + NORM_EPS); return r; }
    __device__ __forceinline__ Ctx prep(const pg8::Unit& u, int col) const { Ctx c; const float* sp = sv + (size_t)(u.pm >> 3) * FF + col; c.s0 = *(const GAS f32x4*)sp; c.s1 = *(const GAS f32x4*)(sp + 16); return c; }
    __device__ __forceinline__ Ld load(const Ctx&, const pg8::Unit&, int, int) const { Ld l; l.d = 0; return l; }
    __device__ __forceinline__ void finish(const Ctx& c, const pg8::Unit&, int row, int col, const Row& rw, const Ld&, f32x4 v0, f32x4 v1, int) const {
        const float rs = rw.rs;
        const f32x4 z = {0.f, 0.f, 0.f, 0.f};
        f32x4 a = __builtin_elementwise_max(v0 * rs + c.s0, z), b = __builtin_elementwise_max(v1 * rs + c.s1, z);
        bf16_t* o = U + (size_t)row * FF + col; st4bf(o, a * a); st4bf(o + 16, b * b); }
    __device__ __forceinline__ void post(const pg8::Unit&, int, int) const {}
};

struct EpiAll {
    int kind; unsigned char* ws; float* xo; const float* base; const float* gate; const float* gn; const float* scn; const float* sv; LAS float* part;
    template <class F> __device__ __forceinline__ void run(const F& f, const f32x4 (&acc)[2][2][4][2], const pg8::Unit& u, int wr, int wc) const { pg8::Epi<F> e{f}; e(acc, u, wr, wc, 0, 0); }
    __device__ __forceinline__ void operator()(const f32x4 (&acc)[2][2][4][2], const pg8::Unit& u, int wr, int wc, int, int) const {
        const float* cosT = (const float*)(ws + WS_COS); const float* sinT = (const float*)(ws + WS_SIN); float* xstat = (float*)(ws + WS_XSTAT); float* lstat = (float*)(ws + WS_LSTAT);
        if (kind == 0) run(F_ProjA{(bf16_t*)(ws + WS_P), xstat, sv, lstat, (bf16_t*)(ws + WS_KPE), cosT, sinT}, acc, u, wr, wc);
        else if (kind == 1) run(F_Qup{(bf16_t*)(ws + WS_QF), cosT, sinT, lstat}, acc, u, wr, wc);
        else if (kind == 2) run(F_Kvup{(bf16_t*)(ws + WS_KV), lstat}, acc, u, wr, wc);
        else if (kind == 3) run(F_Gate{(const bf16_t*)(ws + WS_P), (bf16_t*)(ws + WS_QF)}, acc, u, wr, wc);
        else if (kind == 4) run(F_Resid{base, xo, gate, gn, scn, (bf16_t*)(ws + WS_H), xstat, part}, acc, u, wr, wc);
        else run(F_Sqrelu{(bf16_t*)(ws + WS_P), xstat, sv}, acc, u, wr, wc);
    }
};

__device__ __forceinline__ int crow(int r, int hi) { return (r & 3) + 8 * (r >> 2) + 4 * hi; }
typedef short v4i16_t __attribute__((ext_vector_type(4)));
__device__ __forceinline__ s16x4 vtr(const LAS unsigned char* p) { return __builtin_bit_cast(s16x4, __builtin_amdgcn_ds_read_tr16_b64_v4i16((LAS v4i16_t*)p)); }

__device__ __forceinline__ float prod_halves(float v) { float a = v, b = v; swap32(a, b); return a * b; }
template <bool DIAG>
__device__ __forceinline__ void sb_half(const f32x16& y16, float& Rp, int kb, int tq, int hi, u32x4& pwa, u32x4& pwb) {
    float s[16], f[16];
#pragma unroll
    for (int r = 0; r < 16; ++r) {
        const float y = y16[r];
        const float e = __builtin_amdgcn_exp2f(-fabsf(y));
        const float rr = __builtin_amdgcn_rcpf(1.0f + e), er = e * rr;
        const bool pos = y >= 0.f;
        float sg = pos ? rr : er, fl = pos ? er : rr;
        if (DIAG) { const bool valid = (kb + crow(r, hi)) < tq; sg = valid ? sg : 0.f; fl = valid ? fl : 1.0f; }
        s[r] = sg; f[r] = fl;
    }
    float G[4], OS[4];
#pragma unroll
    for (int g = 0; g < 4; ++g) G[g] = (f[4 * g] * f[4 * g + 1]) * (f[4 * g + 2] * f[4 * g + 3]);
    OS[3] = G[3];
#pragma unroll
    for (int g = 2; g >= 0; --g) OS[g] = G[g] * OS[g + 1];
    const float T = prod_halves(OS[0]);
#pragma unroll
    for (int g = 0; g < 4; ++g) {
        const float ex = (g < 3) ? OS[g + 1] : 1.0f;
        const float snd = hi ? OS[g] : ex;
        const float rcv = other_half(snd, hi);
        float w = (Rp * ex) * rcv;
        const float a3 = s[4 * g + 3] * w; w *= f[4 * g + 3];
        const float a2 = s[4 * g + 2] * w; w *= f[4 * g + 2];
        const float a1 = s[4 * g + 1] * w; w *= f[4 * g + 1];
        const float a0 = s[4 * g] * w;
        const unsigned lo = cvtpk(a0, a1), up = cvtpk(a2, a3);
        if (g == 0) { pwa[0] = lo; pwa[1] = up; } else if (g == 1) { pwa[2] = lo; pwa[3] = up; } else if (g == 2) { pwb[0] = lo; pwb[1] = up; } else { pwb[2] = lo; pwb[3] = up; }
    }
    Rp *= T;
}
template <bool DIAG>
__device__ __forceinline__ float sm_weights(f32x16& p0, f32x16& p1, float& m, float& l, int kb, int tq, int hi, u32x4 (&pw)[4]) {
    if (DIAG) {
#pragma unroll
        for (int r = 0; r < 16; ++r) { const int key = kb + crow(r, hi); if (key > tq) p0[r] = -INFINITY; if (key + 32 > tq) p1[r] = -INFINITY; }
    }
    float mx = fmaxf(p0[0], p1[0]);
#pragma unroll
    for (int r = 1; r < 16; ++r) mx = fmaxf(mx, fmaxf(p0[r], p1[r]));
    mx = max_halves(mx);
    const float mn = fmaxf(m, mx), alpha = __builtin_amdgcn_exp2f(m - mn);
    m = mn;
    float sum = 0.f;
#pragma unroll
    for (int j = 0; j < 8; ++j) {
        const float a = __builtin_amdgcn_exp2f(p0[2 * j] - mn), b = __builtin_amdgcn_exp2f(p0[2 * j + 1] - mn), c = __builtin_amdgcn_exp2f(p1[2 * j] - mn), d = __builtin_amdgcn_exp2f(p1[2 * j + 1] - mn);
        sum += (a + b) + (c + d);
        pw[j >> 2][j & 3] = cvtpk(a, b); pw[2 + (j >> 2)][j & 3] = cvtpk(c, d);
    }
    l = l * alpha + sum;
    return alpha;
}

template <bool MLA>
__device__ __forceinline__ void attn_tile(const LAS unsigned char* Kb, const LAS unsigned char* Vb, const bf16x8 (&qr)[MLA ? 6 : 4], f32x16& o0, f32x16& o1, float& R, float& m_run, float& l_run,
                                          int kb, int tq, int hi, bool diag) {
    constexpr int NKS = MLA ? 6 : 4;
    u32x4 pw[4];
    if (MLA) {
        f32x16 p0, p1;
#pragma unroll
        for (int r = 0; r < 16; ++r) { p0[r] = 0.f; p1[r] = 0.f; }
#pragma unroll
        for (int ks = 0; ks < NKS; ++ks) {
            const bf16x8 k0 = *(const LAS bf16x8*)(Kb + ks * 2048), k1 = *(const LAS bf16x8*)(Kb + ks * 2048 + 512);
            p0 = MFMA32(k0, qr[ks], p0); p1 = MFMA32(k1, qr[ks], p1);
        }
        float alpha;
        if (diag) alpha = sm_weights<true>(p0, p1, m_run, l_run, kb, tq, hi, pw); else alpha = sm_weights<false>(p0, p1, m_run, l_run, kb, tq, hi, pw);
#pragma unroll
        for (int r = 0; r < 16; ++r) { o0[r] *= alpha; o1[r] *= alpha; }
    } else {
#pragma unroll
        for (int sub = 1; sub >= 0; --sub) {
            f32x16 p;
#pragma unroll
            for (int r = 0; r < 16; ++r) p[r] = 0.f;
#pragma unroll
            for (int ks = 0; ks < NKS; ++ks) { const bf16x8 kf = *(const LAS bf16x8*)(Kb + ks * 2048 + sub * 512); p = MFMA32(kf, qr[ks], p); }
            if (diag) sb_half<true>(p, R, kb + 32 * sub, tq, hi, pw[2 * sub], pw[2 * sub + 1]); else sb_half<false>(p, R, kb + 32 * sub, tq, hi, pw[2 * sub], pw[2 * sub + 1]);
        }
    }
#pragma unroll
    for (int ks = 0; ks < 4; ++ks) {
        const bf16x8 pa = __builtin_bit_cast(bf16x8, pw[ks]);
        const s16x4 a0 = vtr(Vb + ks * 1024), a1 = vtr(Vb + ks * 1024 + 512), c0 = vtr(Vb + 4096 + ks * 1024), c1 = vtr(Vb + 4096 + ks * 1024 + 512);
        const bf16x8 v0 = {a0[0], a0[1], a0[2], a0[3], a1[0], a1[1], a1[2], a1[3]}, v1 = {c0[0], c0[1], c0[2], c0[3], c1[0], c1[1], c1[2], c1[3]};
        o0 = MFMA32(v0, pa, o0); o1 = MFMA32(v1, pa, o1);
    }
}

struct AttnStage { u32x4 k, v, k2; };
template <bool MLA>
__device__ __forceinline__ void attn_unit(LAS unsigned char* lds, int tid, int b, int qb,
                                          const bf16_t* Qp, int qpitch, int qoff, const bf16_t* Kp, int kpitch, int koff, const bf16_t* KPE,
                                          const bf16_t* Vp, int vpitch, int voff, bf16_t* Op, int opitch, int ooff, unsigned* dbg_ctr = nullptr) {
    asm volatile("" : "+v"(tid));
    constexpr int NKS = MLA ? 6 : 4;
    constexpr int BUFB = 20480, VOFF = 12288;
    const int lane = tid & 63, r32 = lane & 31, hi = lane >> 5;
    const int wid = __builtin_amdgcn_readfirstlane(tid >> 6);
    const size_t rowbase = (size_t)b * SEQ;
    const int q0 = qb * 256, tq = q0 + wid * 32 + r32, nt = 4 * qb + 4, wlast = 4 * qb + (wid >> 1);
    bf16x8 qr[NKS];
    { const bf16_t* qrow = Qp + (rowbase + tq) * qpitch + qoff + hi * 8;
#pragma unroll
      for (int ks = 0; ks < NKS; ++ks) qr[ks] = *(const GAS bf16x8*)(qrow + ks * 16); }
    const bf16_t* ksrc = Kp + (rowbase + lane) * kpitch + koff + wid * 8;
    const bf16_t* k2src = KPE + (rowbase + lane) * 32 + (wid & 3) * 8;
    const bf16_t* vsrc = Vp + (rowbase + 16 * (wid & 3) + (lane >> 2)) * vpitch + voff + (wid >> 2) * 32 + (lane & 3) * 8;
    const int kdst = wid * 1024 + lane * 16, k2dst = (8 + (wid & 3)) * 1024 + lane * 16, vdst = VOFF + wid * 1024 + lane * 16;
    const int kfrag = hi * 1024 + r32 * 16;
    const int vfrag = VOFF + ((lane >> 4) & 1) * 32 + (lane & 3) * 8 + (4 * hi + ((lane & 15) >> 2)) * 64;
    f32x16 o0, o1;
#pragma unroll
    for (int r = 0; r < 16; ++r) { o0[r] = 0.f; o1[r] = 0.f; }
    float R = 1.0f, m_run = -INFINITY, l_run = 0.f;
    AttnStage RA, RB;
#define TILE_OF(i) (MLA ? (i) : (nt - 1 - (i)))
#define LOADT(S, kt) do { S.k = *(const GAS u32x4*)(ksrc + (size_t)(kt) * 64 * kpitch); S.v = *(const GAS u32x4*)(vsrc + (size_t)(kt) * 64 * vpitch); \
        if (MLA) S.k2 = *(const GAS u32x4*)(k2src + (size_t)(kt) * 64 * 32); } while (0)
#define WRITET(S, bo) do { *(LAS u32x4*)(lds + (bo) + kdst) = S.k; *(LAS u32x4*)(lds + (bo) + vdst) = S.v; \
        if (MLA && wid < 4) *(LAS u32x4*)(lds + (bo) + k2dst) = S.k2; } while (0)
    constexpr float SB_EXIT = 3.5527136788005009e-15f;
    volatile LAS unsigned* cnt = (volatile LAS unsigned*)(lds + 3 * BUFB);
    if (!MLA && tid == 0) { cnt[0] = 0u; cnt[1] = 0u; cnt[2] = 0u; }
    bool wdone = false, stop = false; int ci = 0, bcur = 0; int dbg_iters = 0; (void)dbg_iters;
#define STEP(i_, SL, SW) do { const int i = (i_); const int kt = TILE_OF(i); const int cn = (ci == 2) ? 0 : ci + 1; const int bnext = (bcur == 2 * BUFB) ? 0 : bcur + BUFB; \
        if (!MLA && tid == 0) cnt[cn] = 0u; \
        if (i + 2 < nt) LOADT(SL, TILE_OF(i + 2)); \
        if (kt <= wlast && !wdone) { \
            attn_tile<MLA>(lds + bcur + kfrag, lds + bcur + vfrag, qr, o0, o1, R, m_run, l_run, kt * 64, tq, hi, kt == wlast); \
            if (!MLA) wdone = (__builtin_amdgcn_ballot_w64(R > SB_EXIT) == 0ull); } \
        if (!MLA && wdone && lane == 0) __hip_atomic_fetch_add((LAS unsigned*)(lds + 3 * BUFB) + ci, 1u, __ATOMIC_RELAXED, __HIP_MEMORY_SCOPE_WORKGROUP); \
        if (i + 1 < nt) WRITET(SW, bnext); \
        __syncthreads(); \
        if (!MLA) { if (cnt[ci] == (unsigned)NWAVES) stop = true; ci = cn; } \
        bcur = bnext; dbg_iters++; } while (0)
    LOADT(RA, TILE_OF(0)); WRITET(RA, 0); LOADT(RB, TILE_OF(1)); __syncthreads();
    for (int i2 = 0; i2 < nt; i2 += 2) {
        STEP(i2, RA, RB); if (stop) break;
        STEP(i2 + 1, RB, RA); if (stop) break;
    }
    if (!MLA) __syncthreads();
#ifdef DBG_STAT
    if (!MLA && tid == 0) atomicAdd(dbg_ctr, (unsigned)(bcur == 0 ? 0 : 0) + (unsigned)dbg_iters);
#endif
#undef STEP
#undef TILE_OF
#undef LOADT
#undef WRITET
    if (MLA) { const float lt = sum_halves(l_run); const float inv = 1.0f / lt;
#pragma unroll
        for (int r = 0; r < 16; ++r) { o0[r] *= inv; o1[r] *= inv; } }
    bf16_t* orow = Op + (rowbase + tq) * opitch + ooff + 4 * hi;
#pragma unroll
    for (int g = 0; g < 4; ++g) {
        st4bf(orow + 8 * g, (f32x4){o0[4 * g], o0[4 * g + 1], o0[4 * g + 2], o0[4 * g + 3]});
        st4bf(orow + 32 + 8 * g, (f32x4){o1[4 * g], o1[4 * g + 1], o1[4 * g + 2], o1[4 * g + 3]});
    }
}

#ifndef DBG_NAIVE_SB
#define DBG_NAIVE_SB 0
#endif
#ifndef DBG_NAIVE_MLA
#define DBG_NAIVE_MLA 0
#endif
template <bool MLA>
__device__ __forceinline__ void naive_attn(int gtid, int nthreads, const bf16_t* Qp, int qpitch, int qstride_h, const bf16_t* Kp, int kpitch, int kstride_h, int koff0, const bf16_t* KPE,
                                           const bf16_t* Vp, int vpitch, int vstride_h, int voff0, bf16_t* Op) {
    constexpr int DK = MLA ? 96 : 64;
    for (int idx = gtid; idx < NB * 8 * SEQ; idx += nthreads) {
        const int t = idx % SEQ, h = (idx / SEQ) % 8, b = idx / (SEQ * 8);
        const size_t rowbase = (size_t)b * SEQ;
        float q[DK];
#pragma unroll
        for (int d = 0; d < DK; ++d) q[d] = bf2f(((const GAS bf16_t*)Qp)[(rowbase + t) * qpitch + h * qstride_h + d]);
        float o[64];
#pragma unroll
        for (int d = 0; d < 64; ++d) o[d] = 0.f;
        float R = 0.f, m = -INFINITY, l = 0.f;
        const int s_top = __builtin_amdgcn_readfirstlane(t & ~63) + 63;
        for (int s = s_top; s >= 0; --s) {
            const bool valid = MLA ? (s <= t) : (s < t);
            const GAS bf16_t* kr = (const GAS bf16_t*)Kp + (rowbase + s) * kpitch + koff0 + h * kstride_h;
            float y = 0.f;
#pragma unroll
            for (int d = 0; d < 64; ++d) y += q[d] * bf2f(kr[d]);
            if (MLA) {
                const GAS bf16_t* kp2 = (const GAS bf16_t*)KPE + (rowbase + s) * 32;
#pragma unroll
                for (int d = 0; d < 32; ++d) y += q[64 + d] * bf2f(kp2[d]);
            }
            float w = 0.f;
            if (MLA) {
                if (valid) { const float mn = fmaxf(m, y), al = exp2f(m - mn); w = exp2f(y - mn); l = l * al + w; m = mn;
#pragma unroll
                    for (int d = 0; d < 64; ++d) o[d] *= al; }
            } else {
                if (valid) { const float sp = fmaxf(y, 0.f) + log2f(1.0f + exp2f(-fabsf(y))); w = exp2f((y - sp) + R); R -= sp; }
            }
            const GAS bf16_t* vr = (const GAS bf16_t*)Vp + (rowbase + s) * vpitch + voff0 + h * vstride_h;
#pragma unroll
            for (int d = 0; d < 64; ++d) o[d] += w * bf2f(vr[d]);
        }
        const float inv = MLA ? 1.0f / l : 1.0f;
#pragma unroll
        for (int d = 0; d < 64; d += 2) { const unsigned pk = cvtpk(o[d] * inv, o[d + 1] * inv); *(GAS unsigned*)(Op + (rowbase + t) * 512 + h * 64 + d) = pk; }
    }
}

typedef GAS unsigned gu32;
#define RLX_AGENT __ATOMIC_RELAXED, __HIP_MEMORY_SCOPE_AGENT
#define XB_TMO      128
#define XB_XCNT(j)  (256  + 64 * (j))
#define XB_XSUB(j)  (1280 + 64 * (j))
#define XB_XGEN(j)  (2304 + 64 * (j))
#define XB_TOP      3328
#define XB_TOPGEN   3392
#define XCD_BAR_WORDS 3456
#define XB_SPIN_CAP (1u << 18)
constexpr int CW_BAR = 4096;
constexpr int CW_QUEUE = 200000;
__device__ __forceinline__ unsigned xb_ld(unsigned* p)              { return __hip_atomic_load(p, __ATOMIC_RELAXED, __HIP_MEMORY_SCOPE_AGENT); }
__device__ __forceinline__ unsigned xb_add(unsigned* p, unsigned v) { return __hip_atomic_fetch_add(p, v, __ATOMIC_RELAXED, __HIP_MEMORY_SCOPE_AGENT); }
__device__ __forceinline__ unsigned xb_xcc_id() { return (unsigned)__builtin_amdgcn_s_getreg((3 << 11) | 20) & 0xFu; }
#define XB_SPIN(cond, bar) do { unsigned _sp = 0; while (cond) { __builtin_amdgcn_s_sleep(1); \
    if ((++_sp & 255u) == 0u) { if (xb_ld(&(bar)[XB_TMO])) break; if (_sp > XB_SPIN_CAP) { atomicAdd(&(bar)[XB_TMO], 1u); break; } } } } while (0)
struct XcdBarrier { unsigned* bar; unsigned x; volatile LAS unsigned* st; };
__device__ __forceinline__ XcdBarrier xcd_barrier_post(unsigned* bar, volatile LAS unsigned* st) {
    XcdBarrier b; b.bar = bar; b.x = xb_xcc_id(); b.st = st;
    if (threadIdx.x == 0) (void)xb_add(&bar[XB_XCNT(b.x)], 1u);
    return b;
}
__device__ __forceinline__ void xcd_barrier_complete(unsigned* bar, unsigned x, unsigned& nloc, unsigned& nx) {
    const unsigned G = gridDim.x * gridDim.y * gridDim.z;
    unsigned sum, cnt, mine, sp = 0u;
    for (;;) {
        sum = 0u; cnt = 0u; mine = 0u;
#pragma unroll 1
        for (unsigned j = 0; j < 16; ++j) { const unsigned c = xb_ld(&bar[XB_XCNT(j)]); sum += c; cnt += (c > 0u) ? 1u : 0u; mine = (j == x) ? c : mine; }
        if (sum == G) break;
        __builtin_amdgcn_s_sleep(1);
        if ((++sp & 255u) == 0u) { if (xb_ld(&bar[XB_TMO])) break; if (sp > XB_SPIN_CAP) { atomicAdd(&bar[XB_TMO], 1u); break; } }
    }
    nloc = mine > 0u ? mine : 1u; nx = cnt > 0u ? cnt : 1u;
}
__device__ __forceinline__ void xcd_barrier(const XcdBarrier& b) {
    asm volatile("s_waitcnt vmcnt(0)" ::: "memory");
    __syncthreads();
    if (threadIdx.x == 0) {
        unsigned* bar = b.bar;
        __builtin_amdgcn_s_waitcnt(0);
        unsigned nloc = b.st[0], nx = b.st[1];
        if (nloc == 0u) { xcd_barrier_complete(bar, b.x, nloc, nx); b.st[0] = nloc; b.st[1] = nx; }
        const unsigned old = xb_add(&bar[XB_XSUB(b.x)], 1u);
        const unsigned gen = old / nloc;
        if (old + 1u == (gen + 1u) * nloc) {
            __builtin_amdgcn_fence(__ATOMIC_RELEASE, "agent");
            asm volatile("s_waitcnt vmcnt(0)" ::: "memory");
            const unsigned og = xb_add(&bar[XB_TOP], 1u);
            const unsigned tg = og / nx;
            if (og + 1u == (tg + 1u) * nx) xb_add(&bar[XB_TOPGEN], 1u);
            else XB_SPIN(xb_ld(&bar[XB_TOPGEN]) == tg, bar);
            __builtin_amdgcn_fence(__ATOMIC_ACQUIRE, "agent");
            xb_add(&bar[XB_XGEN(b.x)], 1u);
            asm volatile("s_waitcnt vmcnt(0)" ::: "memory");
        } else {
            XB_SPIN(xb_ld(&bar[XB_XGEN(b.x)]) == gen, bar);
            __builtin_amdgcn_fence(__ATOMIC_ACQUIRE, "agent");
            asm volatile("s_waitcnt vmcnt(0)" ::: "memory");
        }
    }
    __syncthreads();
}

struct Args { const void* in[18]; float* out; unsigned char* ws; int ph_lo, ph_hi; };
struct Frame {
    LAS unsigned char* lds;
    int tid, lane, wave, vcu, G;
};
typedef const void* cvp_t;
__device__ __forceinline__ const void* arg_in(int i) { const __attribute__((address_space(4))) cvp_t* p = (const __attribute__((address_space(4))) cvp_t*)__builtin_amdgcn_kernarg_segment_ptr(); asm volatile("" : "+s"(p)); return p[i]; }

__device__ __forceinline__ void transpose_item(const float* W, int K, int N, bf16_t* WT, int thresh, int add, const float* gain, LAS float* scr, int item, int lane) {
    const int nblk = N / 32, kb = item / nblk, nb = item % nblk, k0 = 64 * kb, n0 = 32 * nb;
#pragma unroll 8
    for (int i = 0; i < 32; ++i) { const int kk = 2 * i + (lane >> 5); scr[kk * 33 + (lane & 31)] = ((const GAS float*)W)[(size_t)(k0 + kk) * N + n0 + (lane & 31)]; }
    LDS_WAIT(); asm volatile("" ::: "memory");
    const int c = lane & 7;
    float gv[8];
#pragma unroll
    for (int e = 0; e < 8; ++e) gv[e] = gain ? ((const GAS float*)gain)[k0 + 8 * c + e] : 1.0f;
    const int radd = (n0 >= thresh) ? add : 0;
#pragma unroll
    for (int j = 0; j < 4; ++j) { const int n = (lane >> 3) + 8 * j; const LAS float* s = scr + (8 * c) * 33 + n;
        u32x4 o; o.x = cvtpk(s[0 * 33] * gv[0], s[1 * 33] * gv[1]); o.y = cvtpk(s[2 * 33] * gv[2], s[3 * 33] * gv[3]); o.z = cvtpk(s[4 * 33] * gv[4], s[5 * 33] * gv[5]); o.w = cvtpk(s[6 * 33] * gv[6], s[7 * 33] * gv[7]);
        *(GAS u32x4*)(WT + (size_t)(radd + n0 + n) * K + k0 + 8 * c) = o; }
    LDS_WAIT(); asm volatile("" ::: "memory");
}

__device__ __forceinline__ void gemv8_item(const Frame& F, const LAS float* vec, LAS float* red, const float* W, int ldw, int n0, int nvalid, const float* bias, float* out, size_t ostride, int split, int add) {
    const int n = F.tid & 31, kc = F.tid >> 5; const bool ok = (n0 + n) < nvalid;
    const GAS float* w = (const GAS float*)W + (size_t)(kc * 64) * ldw + n0 + (ok ? n : 0);
    float acc[8];
#pragma unroll
    for (int b = 0; b < 8; ++b) acc[b] = 0.f;
#pragma unroll 1
    for (int k0 = 0; k0 < 64; k0 += 16) {
        float wv[16];
#pragma unroll
        for (int k = 0; k < 16; ++k) wv[k] = w[(size_t)(k0 + k) * ldw];
#pragma unroll
        for (int k = 0; k < 16; ++k)
#pragma unroll
            for (int b = 0; b < 8; ++b) acc[b] += wv[k] * vec[b * DM + kc * 64 + k0 + k];
    }
#pragma unroll
    for (int b = 0; b < 8; ++b) red[(kc * 8 + b) * 32 + n] = acc[b];
    __syncthreads();
    if (F.tid < 256) { const int b = F.tid >> 5; float s = (bias && ok) ? ((const GAS float*)bias)[n0 + n] : 0.f;
#pragma unroll
      for (int k2 = 0; k2 < 16; ++k2) s += red[(k2 * 8 + b) * 32 + n];
      if (ok) ((GAS float*)out)[(size_t)b * ostride + (n0 + n) + ((n0 + n) >= split ? add : 0)] = s; }
    __syncthreads();
}
__device__ __forceinline__ void phase_p0a(const Frame& F, unsigned char* ws) {
    const int gt = blockIdx.x * 512 + F.tid, NT = F.G * 512;
    { const int* pos = (const int*)arg_in(2); float* cosT = (float*)(ws + WS_COS); float* sinT = (float*)(ws + WS_SIN);
      for (int idx = gt; idx < MTOK * 16; idx += NT) { const int t = idx >> 4, i = idx & 15;
          const float inv = 1.0f / __builtin_amdgcn_exp2f((float)(2 * i) * (13.287712379549449f / 32.0f));
          const float ang = (float)((const GAS int*)pos)[t] * inv;
          double rev = (double)ang * 0.15915494309189535; rev -= __builtin_rint(rev);
          const float fr = (float)rev;
          ((GAS float*)cosT)[idx] = __builtin_amdgcn_cosf(fr); ((GAS float*)sinT)[idx] = __builtin_amdgcn_sinf(fr); } }
    { const float* c = (const float*)arg_in(1); LAS float* cact = (LAS float*)F.lds; LAS float* red = (LAS float*)(F.lds + 32768);
      for (int i = F.tid; i < NB * DM; i += 512) { const float v = ((const GAS float*)c)[i]; cact[i] = v / (1.0f + __expf(-v)); }
      __syncthreads();
      for (int item = blockIdx.x; item < DEPTH * 192; item += F.G) { const int l = item / 192, n0 = (item % 192) * 32;
          gemv8_item(F, cact, red, (const float*)arg_in(3) + (size_t)l * DM * (6 * DM), 6 * DM, n0, 6 * DM, (const float*)arg_in(4) + l * (6 * DM), (float*)(ws + WS_MODS) + (size_t)l * NB * (6 * DM), 6 * DM, 1 << 30, 0); } }
}
__device__ __forceinline__ void phase_p0b(const Frame& F, unsigned char* ws) {
    const int gt = blockIdx.x * 512 + F.tid, NT = F.G * 512;
    const float* mods = (const float*)(ws + WS_MODS);
    { LAS float* vec = (LAS float*)F.lds; LAS float* red = (LAS float*)(F.lds + 32768);
      constexpr int I1 = IN_NAT / 32, I2 = FF / 32;
      for (int item = blockIdx.x; item < DEPTH * (I1 + I2); item += F.G) {
          const int l = item / (I1 + I2), r = item % (I1 + I2); const bool up = r >= I1; const int part = up ? 3 : 0;
          for (int i = F.tid; i < NB * DM; i += 512) vec[i] = ((const GAS float*)mods)[((size_t)l * NB + (i >> 10)) * (6 * DM) + part * DM + (i & 1023)];
          __syncthreads();
          if (!up) { const int n0 = r * 32; gemv8_item(F, vec, red, (const float*)arg_in(6) + (size_t)l * DM * IN_NAT, IN_NAT, n0, IN_NAT, nullptr, (float*)(ws + WS_SV1) + (size_t)l * NB * NPJ, NPJ, IN_SPLIT, NPJ - IN_NAT); }
          else { const int n0 = (r - I1) * 32; gemv8_item(F, vec, red, (const float*)arg_in(15) + (size_t)l * DM * FF, FF, n0, FF, nullptr, (float*)(ws + WS_SV2) + (size_t)l * NB * FF, FF, 1 << 30, 0); }
      }
      for (int idx = gt; idx < DEPTH * NB * (C_GSB - IN_SPLIT); idx += NT) { const int c = idx % (C_GSB - IN_SPLIT), lb = idx / (C_GSB - IN_SPLIT); ((GAS float*)(ws + WS_SV1))[(size_t)lb * NPJ + IN_SPLIT + c] = 0.f; }
    }
    { LAS float* scr = (LAS float*)(F.lds + F.wave * 16384);
      const int gw = F.vcu * NWAVES + F.wave, NGW = F.G * NWAVES;
      constexpr int I_IN = (DM / 64) * (IN_NAT / 32), I_QUP = (QRANK / 64) * (QFULL / 32), I_KVUP = (KVRANK / 64) * (KVW / 32), I_SB = (512 / 64) * (DM / 32), I_MIX = (DM / 64) * (DM / 32),
                    I_UP = (DM / 64) * (FF / 32), I_DOWN = (FF / 64) * (DM / 32), I_LAYER = I_IN + I_QUP + I_KVUP + 2 * I_SB + I_MIX + I_UP + I_DOWN;
      for (int it = gw; it < DEPTH * I_LAYER; it += NGW) {
          const int l = it / I_LAYER; int r = it % I_LAYER;
          unsigned char* wl = ws + WS_W + (size_t)l * LAYER_W;
          if (r < I_IN) { transpose_item((const float*)arg_in(6) + (size_t)l * DM * IN_NAT, DM, IN_NAT, (bf16_t*)(wl + OW_IN), IN_SPLIT, NPJ - IN_NAT, nullptr, scr, r, F.lane); continue; } r -= I_IN;
          if (r < I_QUP) { transpose_item((const float*)arg_in(8) + (size_t)l * QRANK * QFULL, QRANK, QFULL, (bf16_t*)(wl + OW_QUP), 1 << 30, 0, (const float*)arg_in(7) + l * QRANK, scr, r, F.lane); continue; } r -= I_QUP;
          if (r < I_KVUP) { transpose_item((const float*)arg_in(10) + (size_t)l * KVRANK * KVW, KVRANK, KVW, (bf16_t*)(wl + OW_KVUP), 1 << 30, 0, (const float*)arg_in(9) + l * KVRANK, scr, r, F.lane); continue; } r -= I_KVUP;
          if (r < I_SB) { transpose_item((const float*)arg_in(11) + (size_t)l * 512 * DM, 512, DM, (bf16_t*)(wl + OW_SB), 1 << 30, 0, nullptr, scr, r, F.lane); continue; } r -= I_SB;
          if (r < I_SB) { transpose_item((const float*)arg_in(12) + (size_t)l * 512 * DM, 512, DM, (bf16_t*)(wl + OW_MLA), 1 << 30, 0, nullptr, scr, r, F.lane); continue; } r -= I_SB;
          if (r < I_MIX) { transpose_item((const float*)arg_in(13) + (size_t)l * DM * DM, DM, DM, (bf16_t*)(wl + OW_MIX), 1 << 30, 0, nullptr, scr, r, F.lane); continue; } r -= I_MIX;
          if (r < I_UP) { transpose_item((const float*)arg_in(15) + (size_t)l * DM * FF, DM, FF, (bf16_t*)(wl + OW_UP), 1 << 30, 0, nullptr, scr, r, F.lane); continue; } r -= I_UP;
          transpose_item((const float*)arg_in(16) + (size_t)l * FF * DM, FF, DM, (bf16_t*)(wl + OW_DOWN), 1 << 30, 0, nullptr, scr, r, F.lane);
      }
      constexpr int ZV = (C_GSB - IN_SPLIT) * DM * 2 / 16;
      unsigned zu = 0u; asm volatile("" : "+v"(zu));
      for (int idx = gt; idx < DEPTH * ZV; idx += NT) { const int l = idx / ZV, r = idx % ZV;
          *(GAS u32x4*)(ws + WS_W + (size_t)l * LAYER_W + OW_IN + (size_t)IN_SPLIT * DM * 2 + (size_t)r * 16) = (u32x4){zu, zu, zu, zu}; }
      const float* x = (const float*)arg_in(0); const float* g = (const float*)arg_in(5);
      for (int m = gw; m < MTOK; m += NGW) {
          const GAS f32x4* xr = (const GAS f32x4*)(x + (size_t)m * DM) + F.lane;
          const float* sc = mods + (size_t)(m >> 11) * (6 * DM) + DM;
          float ss = 0.f;
#pragma unroll
          for (int j = 0; j < 4; ++j) { const int c = 4 * F.lane + 256 * j; const f32x4 v = xr[64 * j]; ss += dot4(v);
              st4bf((bf16_t*)(ws + WS_H) + (size_t)m * DM + c, v * (*(const GAS f32x4*)(g + c) * (1.0f + *(const GAS f32x4*)(sc + c)))); }
          ss = wave_sum(ss);
          if (F.lane == 0) *(GAS f32x4*)(ws + WS_XSTAT + (size_t)m * 16) = (f32x4){ss, 0.f, 0.f, 0.f};
      }
    }
}

__device__ __forceinline__ void phase_final(const Frame& F, float* X, const float* g) {
    const int gw = F.vcu * NWAVES + F.wave, NGW = F.G * NWAVES;
    for (int m = gw; m < MTOK; m += NGW) {
        GAS f32x4* xr = (GAS f32x4*)(X + (size_t)m * DM) + F.lane;
        f32x4 v[4]; float ss = 0.f;
#pragma unroll
        for (int j = 0; j < 4; ++j) { v[j] = xr[64 * j]; ss += (v[j][0] * v[j][0] + v[j][1] * v[j][1]) + (v[j][2] * v[j][2] + v[j][3] * v[j][3]); }
        const float rs = 1.0f / sqrtf(wave_sum(ss) * (1.0f / DM) + NORM_EPS);
#pragma unroll
        for (int j = 0; j < 4; ++j) xr[64 * j] = (v[j] * rs) * *(const GAS f32x4*)(g + 4 * F.lane + 256 * j);
    }
}

constexpr int STEPS = 8;
constexpr int N_PHASES = 3 + STEPS * DEPTH;

__global__ void __launch_bounds__(NWAVES * 64, 2) mk_fwd(Args a) {
    extern __shared__ __attribute__((aligned(16))) unsigned char lds_raw[];
    Frame F;
    F.lds = (LAS unsigned char*)lds_raw;
    F.tid = threadIdx.x; F.lane = F.tid & 63; F.wave = __builtin_amdgcn_readfirstlane(F.tid >> 6);
    F.G = gridDim.x; { const int bx = blockIdx.x; F.vcu = (F.G % 8 == 0) ? (bx % 8) * (F.G / 8) + bx / 8 : bx; }
    unsigned char* ws0 = a.ws;
    volatile LAS unsigned* MISC = (volatile LAS unsigned*)(F.lds + MISC_OFF);
    for (int u = F.tid; u < (LDS_BYTES - LDSCTL_OFF) / 4; u += NWAVES * 64) ((LAS unsigned*)(F.lds + LDSCTL_OFF))[u] = 0u;
    __syncthreads();
    const int lo = a.ph_lo, hi = a.ph_hi;
    XcdBarrier bar; bar.bar = (unsigned*)(ws0 + WS_CTL) + CW_BAR; bar.x = 0; bar.st = nullptr;
    if (hi - lo > 1) bar = xcd_barrier_post((unsigned*)(ws0 + WS_CTL) + CW_BAR, MISC + 8);

#define cosT ((const float*)(ws + WS_COS))
#define sinT ((const float*)(ws + WS_SIN))
#define P    ((bf16_t*)(ws + WS_P))
#define U    ((bf16_t*)(ws + WS_P))
#define QF   ((bf16_t*)(ws + WS_QF))
#define KV   ((bf16_t*)(ws + WS_KV))
#define MG   ((bf16_t*)(ws + WS_QF))
#define KPE  ((bf16_t*)(ws + WS_KPE))
#define H    ((bf16_t*)(ws + WS_H))
#define OSB  ((bf16_t*)(ws + WS_H))
#define OMLA ((bf16_t*)(ws + WS_H) + (size_t)MTOK * 512)
#define X    (a.out)
#define wl (ws + WS_W + (size_t)l * LAYER_W)
#define mods_l ((const float*)(ws + WS_MODS) + (size_t)l * NB * (6 * DM))
#define xin ((l == 0) ? (const float*)arg_in(0) : (const float*)X)

#define REFRESH() { unsigned z_ = 0u; asm volatile("" : "+v"(z_)); const int l_ = (int)__builtin_amdgcn_mbcnt_hi(~0u, __builtin_amdgcn_mbcnt_lo(~0u, z_)); F.lane = l_; F.tid = F.wave * 64 + l_; }
#define FRESH() int bx_; unsigned char* ws; { unsigned z_ = 0u; asm volatile("" : "+v"(z_)); const int l_ = (int)__builtin_amdgcn_mbcnt_hi(~0u, __builtin_amdgcn_mbcnt_lo(~0u, z_)); F.lane = l_; F.tid = F.wave * 64 + l_; \
        bx_ = blockIdx.x; asm volatile("" : "+s"(bx_)); ws = ws0; asm volatile("" : "+s"(ws)); { int g_ = gridDim.x; asm volatile("" : "+s"(g_)); F.G = g_; } }
#ifndef DUP_MASK
#define DUP_MASK 0
#endif
    for (int ph = lo; ph < hi; ++ph) {
        const int l = (ph - 2) / STEPS, t = (ph == 0) ? -1 : (ph == 1) ? -3 : (ph == N_PHASES - 1) ? -2 : (ph - 2) % STEPS;
        bool skip_bar = false;
        for (int rep = (DUP_MASK && t >= 0 && ((DUP_MASK >> t) & 1)) ? 0 : 1; rep < 2; ++rep) {
        if (DUP_MASK && rep == 1 && t >= 0 && ((DUP_MASK >> t) & 1)) xcd_barrier(bar);
        if (t == -1) {
            FRESH(); (void)bx_;
            phase_p0a(F, ws);
        } else if (t == -3) {
            FRESH(); (void)bx_;
            phase_p0b(F, ws);
        } else if (t == -2) {
            FRESH(); (void)bx_; (void)ws;
            phase_final(F, X, (const float*)arg_in(17));
#ifdef DBG_STAT
            VM_WAIT(); __syncthreads(); if (F.vcu == 0 && F.tid == 0) X[0] = (float)__hip_atomic_load((unsigned*)(ws0 + WS_CTL) + 100000, __ATOMIC_RELAXED, __HIP_MEMORY_SCOPE_AGENT) * 0.01f;
#endif
        } else if (t == 3) {
            FRESH(); (void)bx_;
            {
                volatile LAS unsigned* qslot = (volatile LAS unsigned*)(F.lds + LDSCTL_OFF + 512);
                unsigned* qctr = (unsigned*)(ws + WS_CTL) + CW_QUEUE + 64 * (l * 2 + rep);
                for (;;) {
                    if (F.tid == 0) qslot[0] = __hip_atomic_fetch_add(qctr, 1u, __ATOMIC_RELAXED, __HIP_MEMORY_SCOPE_AGENT);
                    __syncthreads();
                    const int idx = (int)qslot[0];
                    __syncthreads();
                    if (idx >= 1024) break;
                    const int j = idx & 511, qb = 7 - (j >> 6), bh = j & 63, b = bh >> 3, h = bh & 7;
                    if (idx < 512) attn_unit<true>(F.lds, F.tid, b, qb, QF, QFULL, h * 96, KV, KVW, h * 128, KPE, KV, KVW, h * 128 + 64, OMLA, 512, h * 64);
                    else attn_unit<false>(F.lds, F.tid, b, qb, P, NPJ, C_QSB + h * 64, P, NPJ, C_KSB + h * 64, KPE, P, NPJ, C_VSB + h * 64, OSB, 512, h * 64);
                }
            }
        } else {
            FRESH();
            pg8::Gemm g; pg8::Order S; EpiAll E; int N = DM, crot = 0;
            g.A2 = nullptr; g.Bt2 = nullptr; S.pair = 0;
            E.ws = ws; E.xo = X; E.base = nullptr; E.gate = nullptr; E.gn = nullptr; E.scn = nullptr; E.sv = nullptr; E.part = (LAS float*)(F.lds + LDSCTL_OFF + 1024);
            if (t == 0) {
                g.A = H; g.Bt = (const bf16_t*)(wl + OW_IN); g.lda = DM; g.ldb = DM; g.K = DM; N = NPJ; E.kind = 0; E.sv = (const float*)(ws + WS_SV1) + (size_t)l * NB * NPJ;
            } else if (t == 1) {
                g.A = P + C_QLAT; g.Bt = (const bf16_t*)(wl + OW_QUP); g.lda = NPJ; g.ldb = QRANK; g.K = QRANK; N = QFULL; E.kind = 1; skip_bar = true;
            } else if (t == 2) {
                g.A = P + C_KVLAT; g.Bt = (const bf16_t*)(wl + OW_KVUP); g.lda = NPJ; g.ldb = KVRANK; g.K = KVRANK; N = KVW; E.kind = 2; crot = 192;
            } else if (t == 4) {
                g.A = OSB; g.Bt = (const bf16_t*)(wl + OW_SB); g.A2 = OMLA; g.Bt2 = (const bf16_t*)(wl + OW_MLA); g.lda = 512; g.ldb = 512; g.K = 512; S.pair = 1; E.kind = 3;
            } else if (t == 6) {
                g.A = H; g.Bt = (const bf16_t*)(wl + OW_UP); g.lda = DM; g.ldb = DM; g.K = DM; N = FF; E.kind = 5; E.sv = (const float*)(ws + WS_SV2) + (size_t)l * NB * FF;
            } else {
                const bool isF = (t == 7);
                g.A = isF ? U : MG; g.Bt = (const bf16_t*)(wl + (isF ? OW_DOWN : OW_MIX)); g.lda = isF ? FF : DM; g.ldb = g.lda; g.K = g.lda;
                E.kind = 4; E.base = isF ? (const float*)X : xin; E.gate = mods_l + (isF ? 5 : 2) * DM;
                const int ln = isF ? ((l + 1 < DEPTH) ? l + 1 : l) : l;
                E.gn = (const float*)arg_in(isF ? 5 : 14) + ln * DM; E.scn = (const float*)(ws + WS_MODS) + (size_t)ln * NB * (6 * DM) + (isF ? 1 : 4) * DM;
            }
            S.s.init(MTOK, N, F.G, (int)(((unsigned)bx_ + (unsigned)crot) % (unsigned)F.G));
            pg8::gemm_phase<EpiAll, pg8::Order, true>(F.lds, F.tid, g, S, E);
        }
        }
        if (ph + 1 < hi && !skip_bar) xcd_barrier(bar);
    }
}

extern "C" void kernel_launch(void* const* d_in, const int* in_sizes, int n_in, void* d_out, int out_size, void* d_ws, size_t ws_size, hipStream_t stream) {
    static int grid = 0;
    if (grid == 0) {
        if (n_in != 18 || in_sizes[0] != MTOK * DM || out_size != MTOK * DM || ws_size < WS_END) {
            fprintf(stderr, "kernel_launch: unexpected shapes (n_in %d, in0 %d, out %d, ws %zu); nothing launched\n", n_in, n_in > 0 ? in_sizes[0] : -1, out_size, ws_size); grid = -1; return; }
        int dev = 0, cus = 0, per_cu = 0;
        if (hipGetDevice(&dev) != hipSuccess || hipDeviceGetAttribute(&cus, hipDeviceAttributeMultiprocessorCount, dev) != hipSuccess) { grid = -1; return; }
        if (hipFuncSetAttribute((const void*)mk_fwd, hipFuncAttributeMaxDynamicSharedMemorySize, LDS_BYTES) != hipSuccess) { fprintf(stderr, "kernel_launch: hipFuncSetAttribute failed\n"); grid = -1; return; }
        if (hipOccupancyMaxActiveBlocksPerMultiprocessor(&per_cu, (const void*)mk_fwd, NWAVES * 64, LDS_BYTES) != hipSuccess || per_cu < 1) {
            fprintf(stderr, "kernel_launch: occupancy query reports %d workgroups per CU; nothing launched\n", per_cu); (void)hipGetLastError(); grid = -1; return; }
        grid = cus;
    }
    if (grid < 0) return;
    (void)hipMemsetAsync((char*)d_ws + WS_CTL, 0, CTL_ZERO_BYTES, stream);
    Args a{};
    for (int i = 0; i < 18; ++i) a.in[i] = d_in[i];
    a.out = (float*)d_out; a.ws = (unsigned char*)d_ws;
#if MK_N_LAUNCHES == 1
    a.ph_lo = 0; a.ph_hi = N_PHASES;
    void* kargs[] = {&a};
    hipError_t e = hipLaunchCooperativeKernel((const void*)mk_fwd, dim3(grid), dim3(NWAVES * 64), kargs, LDS_BYTES, stream);
    if (e != hipSuccess) fprintf(stderr, "kernel_launch: cooperative launch failed: %s (grid %d)\n", hipGetErrorString(e), grid);
#else
    for (int ph = 0; ph < N_PHASES; ++ph) {
        a.ph_lo = ph; a.ph_hi = ph + 1;
        hipLaunchKernelGGL(mk_fwd, dim3(grid), dim3(NWAVES * 64), LDS_BYTES, stream, a);
    }
#endif
}
```

```cpp
#include <hip/hip_runtime.h>
#include <cstdio>
#include <cstdint>

#ifndef MK_N_LAUNCHES
#define MK_N_LAUNCHES 1
#endif

#define LAS __attribute__((address_space(3)))
#define GAS __attribute__((address_space(1)))
typedef unsigned short bf16_t;
typedef short bf16x8 __attribute__((ext_vector_type(8)));
typedef short s16x4 __attribute__((ext_vector_type(4)));
typedef float f32x2 __attribute__((ext_vector_type(2)));
typedef float f32x4 __attribute__((ext_vector_type(4)));
typedef float f32x16 __attribute__((ext_vector_type(16)));
typedef unsigned u32x2 __attribute__((ext_vector_type(2)));
typedef unsigned u32x4 __attribute__((ext_vector_type(4)));
typedef __bf16 bf16x2_t __attribute__((ext_vector_type(2)));

constexpr int DM = 1024, NB = 8, SEQ = 2048, MTOK = NB * SEQ, DEPTH = 4, FF = 4096;
constexpr int NPJ = 4352;
constexpr int C_QSB = 0, C_KSB = 512, C_VSB = 1024, C_QLAT = 1536, C_KVLAT = 1920, C_KROPE = 2176, C_GSB = 2304, C_GMLA = 3328;
constexpr int IN_NAT = 4256, IN_SPLIT = 2208;
constexpr int QRANK = 384, KVRANK = 256, QFULL = 768, KVW = 1024;
constexpr float NORM_EPS = 1e-6f;
constexpr float LOG2E = 1.4426950408889634f;
constexpr float C2SB = 0.125f * LOG2E;
constexpr float C2MLA = 0.10206207261596577f * LOG2E;

constexpr size_t MiB = 1u << 20;
constexpr size_t WS_CTL = 0, CTL_ZERO_BYTES = 1 * MiB;
constexpr size_t WS_COS = 1 * MiB, WS_SIN = 2 * MiB;
constexpr size_t WS_MODS = 3 * MiB;
constexpr size_t WS_XSTAT = 3 * MiB + 786432;
constexpr size_t WS_W = 4 * MiB;
constexpr size_t OW_IN = 0, OW_QUP = OW_IN + (size_t)NPJ * DM * 2, OW_KVUP = OW_QUP + (size_t)QFULL * QRANK * 2, OW_SB = OW_KVUP + (size_t)KVW * KVRANK * 2,
                 OW_MLA = OW_SB + (size_t)DM * 512 * 2, OW_MIX = OW_MLA + (size_t)DM * 512 * 2, OW_UP = OW_MIX + (size_t)DM * DM * 2, OW_DOWN = OW_UP + (size_t)FF * DM * 2,
                 LAYER_W = OW_DOWN + (size_t)DM * FF * 2;
constexpr size_t WS_P = 123 * MiB;
constexpr size_t WS_QF = 259 * MiB;
constexpr size_t WS_KV = 283 * MiB;
constexpr size_t WS_LSTAT = 315 * MiB;
constexpr size_t WS_SV1 = 317 * MiB;
constexpr size_t WS_SV2 = 318 * MiB;
constexpr size_t WS_KPE = 335 * MiB;
constexpr size_t WS_H = 336 * MiB;
constexpr size_t WS_END = 368 * MiB;
static_assert(WS_W + DEPTH * LAYER_W <= WS_P, "weights fit");

constexpr int RING_BYTES = 131072;
constexpr int LDSCTL_OFF = RING_BYTES, MISC_OFF = LDSCTL_OFF + 320;
constexpr int LDS_BYTES = 147456;
constexpr int NWAVES = 8;

#ifndef USE_F16
#define USE_F16 0
#endif
typedef _Float16 half2_t __attribute__((ext_vector_type(2)));
typedef _Float16 half8_t __attribute__((ext_vector_type(8)));
#if USE_F16
__device__ __forceinline__ unsigned cvtpk(float lo, float hi) { f32x2 v = {lo, hi}; half2_t b = __builtin_convertvector(v, half2_t); return __builtin_bit_cast(unsigned, b); }
__device__ __forceinline__ float bf2f(unsigned short h) { return (float)__builtin_bit_cast(_Float16, h); }
__device__ __forceinline__ float up_lo(unsigned w) { return (float)__builtin_bit_cast(half2_t, w)[0]; }
__device__ __forceinline__ float up_hi(unsigned w) { return (float)__builtin_bit_cast(half2_t, w)[1]; }
#define MFMA16(a, b, c) __builtin_amdgcn_mfma_f32_16x16x32_f16(__builtin_bit_cast(half8_t, a), __builtin_bit_cast(half8_t, b), c, 0, 0, 0)
#define MFMA32(a, b, c) __builtin_amdgcn_mfma_f32_32x32x16_f16(__builtin_bit_cast(half8_t, a), __builtin_bit_cast(half8_t, b), c, 0, 0, 0)
#else
__device__ __forceinline__ unsigned cvtpk(float lo, float hi) { f32x2 v = {lo, hi}; bf16x2_t b = __builtin_convertvector(v, bf16x2_t); return __builtin_bit_cast(unsigned, b); }
__device__ __forceinline__ float bf2f(unsigned short h) { return __builtin_bit_cast(float, (unsigned)h << 16); }
__device__ __forceinline__ float up_lo(unsigned w) { return __builtin_bit_cast(float, w << 16); }
__device__ __forceinline__ float up_hi(unsigned w) { return __builtin_bit_cast(float, w & 0xffff0000u); }
#define MFMA16(a, b, c) __builtin_amdgcn_mfma_f32_16x16x32_bf16(a, b, c, 0, 0, 0)
#define MFMA32(a, b, c) __builtin_amdgcn_mfma_f32_32x32x16_bf16(a, b, c, 0, 0, 0)
#endif
__device__ __forceinline__ void st4bf(bf16_t* p, f32x4 v) { u32x2 w; w.x = cvtpk(v[0], v[1]); w.y = cvtpk(v[2], v[3]); *(GAS u32x2*)p = w; }
__device__ __forceinline__ f32x4 bf4(u32x2 w) { f32x4 r; r[0] = up_lo(w.x); r[1] = up_hi(w.x); r[2] = up_lo(w.y); r[3] = up_hi(w.y); return r; }
__device__ __forceinline__ f32x4 ld4bf(const bf16_t* p) { return bf4(*(const GAS u32x2*)p); }
#define swz_xor(v, pat) __builtin_bit_cast(float, __builtin_amdgcn_ds_swizzle(__builtin_bit_cast(int, (float)(v)), (pat)))
__device__ __forceinline__ void swap32(float& a, float& b) { asm volatile("s_nop 1\n\tv_permlane32_swap_b32 %0, %1" : "+v"(a), "+v"(b)); }
__device__ __forceinline__ float sum_halves(float v) { float a = v, b = v; swap32(a, b); return a + b; }
__device__ __forceinline__ float max_halves(float v) { float a = v, b = v; swap32(a, b); return fmaxf(a, b); }
__device__ __forceinline__ float other_half(float v, int hi) { float a = v, b = v; swap32(a, b); return hi ? a : b; }
#ifndef DBG_SHFL_SUM
#define DBG_SHFL_SUM 0
#endif
__device__ __forceinline__ float wave_sum(float v) {
#if DBG_SHFL_SUM
#pragma unroll
    for (int o = 1; o < 64; o <<= 1) v += __shfl_xor(v, o);
    return v;
#else
    v += swz_xor(v, (1 << 10) | 0x1f); v += swz_xor(v, (2 << 10) | 0x1f); v += swz_xor(v, (4 << 10) | 0x1f); v += swz_xor(v, (8 << 10) | 0x1f); v += swz_xor(v, (16 << 10) | 0x1f);
    return sum_halves(v);
#endif
}
#define LDS_WAIT() asm volatile("s_waitcnt lgkmcnt(0)" ::: "memory")
#define VM_WAIT() asm volatile("s_waitcnt vmcnt(0)" ::: "memory")

namespace pg8 {
constexpr int BM = 256, BK = 64, HALF = 128, HTB = HALF * BK * 2, STAGE_BYTES = 8 * HTB, NXCD = 8, WGM = 8;
__host__ __device__ __forceinline__ int lds_byte(int r, int c) { const int st = (r >> 4) * 2 + (c >> 5), rr = r & 15, cc = c & 31, ob = rr * 64 + cc * 2; return st * 1024 + (ob ^ (((ob >> 9) & 1) << 5)); }
__host__ __device__ __forceinline__ void stage_rc(int b, int& R, int& C) { const int st = b / 1024, sb = b % 1024, swz = sb ^ (((sb >> 9) & 1) << 5); R = (st >> 1) * 16 + swz / 64; C = (st & 1) * 32 + (swz % 64) / 2; }

struct Unit { int pm, pn, z; };
struct Gemm { const bf16_t* A; const bf16_t* Bt; const bf16_t* A2; const bf16_t* Bt2; int lda, ldb, K; };

struct StaticOrder {
    int nM, nN, nwg, G, c;
    __host__ __device__ void init(int M, int N, int G_, int c_) { nM = M / BM; nN = N / BM; nwg = nM * nN; G = G_; c = c_; }
    __host__ __device__ bool next(int i, Unit& u) const {
        const long L = (long)i * G + c; if (L >= nwg) return false;
        int wgid = (int)L; { const int q = nwg / NXCD, r = nwg % NXCD, xcd = wgid % NXCD, off = wgid / NXCD; wgid = (xcd < r ? xcd * (q + 1) : r * (q + 1) + (xcd - r) * q) + off; }
        const int nig = WGM * nN, gid = wgid / nig, fm = gid * WGM, gsz = (nM - fm) < WGM ? (nM - fm) : WGM;
        u.pm = fm + ((wgid % nig) % gsz); u.pn = (wgid % nig) / gsz; u.z = 0; return true;
    }
};
struct Order {
    StaticOrder s; int pair;
    __host__ __device__ bool next(int i, Unit& u) const { if (!s.next(pair ? (i >> 1) : i, u)) return false; u.z = pair ? (i & 1) : 0; return true; }
};

template <class F> struct Epi {
    F f;
    __device__ __forceinline__ void operator()(const f32x4 (&acc)[2][2][4][2], const Unit& u, int wr, int wc, int fr, int fq) const {
        { unsigned z_ = 0u; asm volatile("" : "+v"(z_)); const int l_ = (int)__builtin_amdgcn_mbcnt_hi(~0u, __builtin_amdgcn_mbcnt_lo(~0u, z_)); fr = l_ & 15; fq = l_ >> 4; }
        const int row0 = u.pm * BM + wr * 64 + fr;
        typename F::Row rw[8];
#pragma unroll
        for (int it = 0; it < 8; ++it) rw[it] = f.loadrow(u, row0 + (it >> 2) * HALF + (it & 3) * 16);
#pragma unroll
        for (int bj = 0; bj < 2; ++bj) {
            const int col = u.pn * BM + bj * HALF + wc * 32 + 4 * fq;
            const typename F::Ctx cx = f.prep(u, col);
            constexpr int PD = F::PD;
            typename F::Ld q[8];
#pragma unroll
            for (int it = 0; it < PD; ++it) q[it] = f.load(cx, u, row0 + (it >> 2) * HALF + (it & 3) * 16, col);
#pragma unroll
            for (int it = 0; it < 8; ++it) {
                const int ai = it >> 2, m = it & 3, row = row0 + ai * HALF + m * 16;
                if (it + PD < 8) q[it + PD] = f.load(cx, u, row0 + ((it + PD) >> 2) * HALF + ((it + PD) & 3) * 16, col);
                f.finish(cx, u, row, col, rw[it], q[it], acc[ai][bj][m][0], acc[ai][bj][m][1], fq);
                if (PD > 0) asm volatile("" ::: "memory");
            }
        }
        f.post(u, wr * 4 + wc, fr + 16 * fq);
    }
};

template <class EpiT, class Sched, bool ALIGN_EPI>
__device__ __forceinline__ void gemm_phase(LAS unsigned char* lds, int tid, const Gemm g, const Sched& S, const EpiT& E) {
    asm volatile("" : "+v"(tid));
    const int wid = __builtin_amdgcn_readfirstlane(tid >> 6), lane = tid & 63, wr = wid >> 2, wc = wid & 3, fr = lane & 15, fq = lane >> 4;
    const int K = g.K, nt = K / BK;
    unsigned voffA[2], voffB[2];
#pragma unroll
    for (int i = 0; i < 2; ++i) { int R, C; stage_rc(tid * 16 + i * 8192, R, C);
        voffA[i] = (unsigned)(R * g.lda + C) * 2u; voffB[i] = (unsigned)(R * g.ldb + C) * 2u; }
    const size_t kstep = (size_t)(BK * 2);
    const size_t hstepA = (size_t)HALF * g.lda * 2, hstepB = (size_t)HALF * g.ldb * 2;
    const size_t tstepA = 2 * hstepA, tstepB = 2 * hstepB;
    const unsigned ldsw = (unsigned)wid * 1024u;
    const int aoff = lds_byte(wr * 64 + fr, fq * 8), boff = lds_byte(wc * 32 + fr, fq * 8);
#define PG8_SA(b, h) (((b) * 2 + (h)) * HTB)
#define PG8_SB(b, h) ((4 + (b) * 2 + (h)) * HTB)
#define PG8_STAGE(bufoff, gbase, voff) do { _Pragma("unroll") for (int _i = 0; _i < 2; ++_i) \
        __builtin_amdgcn_global_load_lds((const unsigned*)((const char*)(gbase) + (voff)[_i]), (LAS unsigned*)(lds + (bufoff) + ldsw + _i * 8192), 16, 0, 0); } while (0)
#define PG8_LDA(dst, b, h) do { _Pragma("unroll") for (int m = 0; m < 4; ++m) _Pragma("unroll") for (int k = 0; k < 2; ++k) dst[m][k] = *(const LAS bf16x8*)(lds + PG8_SA(b, h) + aoff + m * 2048 + k * 1024); } while (0)
#define PG8_LDB(dst, b, h) do { _Pragma("unroll") for (int n = 0; n < 2; ++n) _Pragma("unroll") for (int k = 0; k < 2; ++k) dst[n][k] = *(const LAS bf16x8*)(lds + PG8_SB(b, h) + boff + n * 2048 + k * 1024); } while (0)
#define PG8_MMA(ai, bj, At, Bt) do { __builtin_amdgcn_s_setprio(1); _Pragma("unroll") for (int m = 0; m < 4; ++m) _Pragma("unroll") for (int n = 0; n < 2; ++n) _Pragma("unroll") for (int k = 0; k < 2; ++k) \
        acc[ai][bj][m][n] = MFMA16(Bt[n][k], At[m][k], acc[ai][bj][m][n]); __builtin_amdgcn_s_setprio(0); } while (0)
#define PG8_WAIT_V(n) asm volatile("s_waitcnt vmcnt(" #n ")" ::: "memory")
#define PG8_WAIT_L(n) asm volatile("s_waitcnt lgkmcnt(" #n ")" ::: "memory")
#define PG8_BAR __builtin_amdgcn_s_barrier()
#define PG8_SCHED __builtin_amdgcn_sched_barrier(0)
    Unit cur, nxt; int ui = 0;
    if (!S.next(0, cur)) return;
    f32x4 acc[2][2][4][2];
    { float zf = 0.f; asm volatile("" : "+v"(zf));
#pragma unroll
    for (int a = 0; a < 2; ++a)
#pragma unroll
        for (int b = 0; b < 2; ++b)
#pragma unroll
            for (int m = 0; m < 4; ++m)
#pragma unroll
                for (int n = 0; n < 2; ++n) acc[a][b][m][n] = (f32x4){zf, zf, zf, zf}; }
    bf16x8 At[4][2], B0[2][2], B1[2][2];
    const char* cA = (const char*)(cur.z ? g.A2 : g.A) + (size_t)cur.pm * tstepA; const char* cB = (const char*)(cur.z ? g.Bt2 : g.Bt) + (size_t)cur.pn * tstepB;
    PG8_STAGE(PG8_SB(0, 0), cB, voffB); PG8_STAGE(PG8_SB(0, 1), cB + hstepB, voffB); PG8_STAGE(PG8_SA(0, 0), cA, voffA); PG8_STAGE(PG8_SA(0, 1), cA + hstepA, voffA);
    if (wr == 1) PG8_BAR;
    PG8_WAIT_V(2); PG8_BAR;
    PG8_STAGE(PG8_SB(1, 0), cB + kstep, voffB); PG8_STAGE(PG8_SA(1, 0), cA + kstep, voffA); PG8_STAGE(PG8_SB(1, 1), cB + hstepB + kstep, voffB);
    PG8_WAIT_V(6); PG8_BAR;
    for (;;) {
        const bool has_next = S.next(ui + 1, nxt);
        const char* nA = has_next ? (const char*)(nxt.z ? g.A2 : g.A) + (size_t)nxt.pm * tstepA : cA; const char* nB = has_next ? (const char*)(nxt.z ? g.Bt2 : g.Bt) + (size_t)nxt.pn * tstepB : cB;
        for (int t = 0; t < nt; t += 2) {
            const bool last = (t == nt - 2);
            const char* a1 = cA + (size_t)(t + 1) * kstep;
            const char* a2 = last ? nA : cA + (size_t)(t + 2) * kstep; const char* b2 = last ? nB : cB + (size_t)(t + 2) * kstep;
            const char* a3 = a2 + kstep; const char* b3 = b2 + kstep;
            PG8_LDB(B0, 0, 0); PG8_LDB(B1, 0, 1); PG8_SCHED; PG8_LDA(At, 0, 0); PG8_STAGE(PG8_SA(1, 1), a1 + hstepA, voffA);
            PG8_WAIT_V(8); PG8_WAIT_L(0); PG8_BAR; PG8_MMA(0, 0, At, B0); PG8_MMA(0, 1, At, B1); PG8_BAR; PG8_SCHED;
            PG8_LDA(At, 0, 1); PG8_STAGE(PG8_SB(0, 0), b2, voffB); PG8_STAGE(PG8_SB(0, 1), b2 + hstepB, voffB); PG8_STAGE(PG8_SA(0, 0), a2, voffA);
            PG8_WAIT_V(8); PG8_WAIT_L(0); PG8_BAR; PG8_MMA(1, 0, At, B0); PG8_MMA(1, 1, At, B1); PG8_BAR; PG8_SCHED;
            PG8_LDB(B0, 1, 0); PG8_LDB(B1, 1, 1); PG8_SCHED; PG8_LDA(At, 1, 0); PG8_STAGE(PG8_SA(0, 1), a2 + hstepA, voffA);
            PG8_WAIT_V(8); PG8_WAIT_L(0); PG8_BAR; PG8_MMA(0, 0, At, B0); PG8_MMA(0, 1, At, B1); PG8_BAR; PG8_SCHED;
            PG8_LDA(At, 1, 1); PG8_STAGE(PG8_SB(1, 0), b3, voffB); PG8_STAGE(PG8_SB(1, 1), b3 + hstepB, voffB); PG8_STAGE(PG8_SA(1, 0), a3, voffA);
            PG8_WAIT_V(8); PG8_WAIT_L(0); PG8_BAR; PG8_MMA(1, 0, At, B0); PG8_MMA(1, 1, At, B1); PG8_BAR; PG8_SCHED;
        }
        if constexpr (ALIGN_EPI) { if (wr == 0) PG8_BAR; }
        E(acc, cur, wr, wc, fr, fq);
#ifdef DUP_EPI
        if (E.kind == 0 || E.kind == 5) { asm volatile("" ::: "memory"); E(acc, cur, wr, wc, fr, fq); }
#endif
        if (!has_next) break;
        { float zf = 0.f; asm volatile("" : "+v"(zf));
#pragma unroll
        for (int a = 0; a < 2; ++a)
#pragma unroll
            for (int b = 0; b < 2; ++b)
#pragma unroll
                for (int m = 0; m < 4; ++m)
#pragma unroll
                    for (int n = 0; n < 2; ++n) acc[a][b][m][n] = (f32x4){zf, zf, zf, zf}; }
        cur = nxt; cA = nA; cB = nB; ++ui;
        if constexpr (ALIGN_EPI) { if (wr == 1) PG8_BAR; }
    }
    PG8_WAIT_V(0);
    if constexpr (!ALIGN_EPI) { if (wr == 0) PG8_BAR; }
    PG8_BAR;
#undef PG8_SA
#undef PG8_SB
#undef PG8_STAGE
#undef PG8_LDA
#undef PG8_LDB
#undef PG8_MMA
#undef PG8_WAIT_V
#undef PG8_WAIT_L
#undef PG8_BAR
#undef PG8_SCHED
}
}

__device__ __forceinline__ float sum_fq(float v) { v += swz_xor(v, (16 << 10) | 0x1f); return sum_halves(v); }
__device__ __forceinline__ float dot4(f32x4 a) { return (a[0] * a[0] + a[1] * a[1]) + (a[2] * a[2] + a[3] * a[3]); }
struct LdNone { int d; };
struct F_ProjA {
    bf16_t* P; const float* xstat; const float* sv; float* lstat; bf16_t* kpe; const float* cosT; const float* sinT;
    struct Ctx { float sc; f32x4 s0, s1; int grp; }; struct Ld { f32x4 ct, sn; }; struct Row { float rs; }; static constexpr int PD = 1;
    __device__ __forceinline__ Row loadrow(const pg8::Unit&, int row) const { const f32x4 xs = *(const GAS f32x4*)(xstat + (size_t)row * 4); Row r; r.rs = 1.0f / sqrtf(((xs[0] + xs[1]) + (xs[2] + xs[3])) * (1.0f / DM) + NORM_EPS); return r; }
    __device__ __forceinline__ Ctx prep(const pg8::Unit& u, int col) const { Ctx c; c.sc = (u.pn < 2) ? C2SB : 1.0f; const float* sp = sv + (size_t)(u.pm >> 3) * NPJ + col;
        c.s0 = *(const GAS f32x4*)sp; c.s1 = *(const GAS f32x4*)(sp + 16); c.grp = col >> 5; return c; }
    __device__ __forceinline__ Ld load(const Ctx& c, const pg8::Unit&, int row, int col) const { Ld l; l.ct = c.s0; l.sn = c.s0;
        if (c.grp == (C_KROPE >> 5)) { l.ct = *(const GAS f32x4*)(cosT + (size_t)row * 16 + (col & 15)); l.sn = *(const GAS f32x4*)(sinT + (size_t)row * 16 + (col & 15)); } return l; }
    __device__ __forceinline__ void finish(const Ctx& c, const pg8::Unit&, int row, int col, const Row& rw, const Ld& l, f32x4 v0, f32x4 v1, int fq) const {
        v0 = v0 * rw.rs + c.s0; v1 = v1 * rw.rs + c.s1;
        if (c.grp >= (C_QLAT >> 5) && c.grp < (C_KROPE >> 5)) {
            const float ss = sum_fq(dot4(v0) + dot4(v1));
            if (fq == 0) ((GAS float*)lstat)[(size_t)row * 24 + (c.grp - (C_QLAT >> 5))] = ss;
        }
        if (c.grp == (C_KROPE >> 5)) {
            const f32x4 a = v0 * l.ct - v1 * l.sn, b = v1 * l.ct + v0 * l.sn;
            bf16_t* ko = kpe + (size_t)row * 32 + (col & 15); st4bf(ko, a); st4bf(ko + 16, b);
        }
        bf16_t* o = P + (size_t)row * NPJ + col; st4bf(o, v0 * c.sc); st4bf(o + 16, v1 * c.sc); }
    __device__ __forceinline__ void post(const pg8::Unit&, int, int) const {}
};
struct F_Qup {
    bf16_t* Q; const float* cosT; const float* sinT; const float* lstat;
    struct Ctx { int rope; }; struct Ld { f32x4 a, b, c, ct, st; }; typedef LdNone Row; static constexpr int PD = 1;
    __device__ __forceinline__ Row loadrow(const pg8::Unit&, int) const { Row r; r.d = 0; return r; }
    __device__ __forceinline__ Ctx prep(const pg8::Unit&, int col) const { Ctx c; c.rope = (((col >> 5) % 3) == 2) ? 1 : 0; return c; }
    __device__ __forceinline__ Ld load(const Ctx&, const pg8::Unit&, int row, int col) const { Ld l; const int i0 = col & 15; const float* ls = lstat + (size_t)row * 24;
        l.a = *(const GAS f32x4*)ls; l.b = *(const GAS f32x4*)(ls + 4); l.c = *(const GAS f32x4*)(ls + 8);
        l.ct = *(const GAS f32x4*)(cosT + (size_t)row * 16 + i0); l.st = *(const GAS f32x4*)(sinT + (size_t)row * 16 + i0); return l; }
    __device__ __forceinline__ void finish(const Ctx& c, const pg8::Unit&, int row, int col, const Row&, const Ld& l, f32x4 v0, f32x4 v1, int) const {
        const f32x4 t = l.a + l.b + l.c; const float rs = 1.0f / sqrtf(((t[0] + t[1]) + (t[2] + t[3])) * (1.0f / QRANK) + NORM_EPS);
        v0 = v0 * rs; v1 = v1 * rs;
        if (c.rope) { const f32x4 a = v0 * l.ct - v1 * l.st, b = v1 * l.ct + v0 * l.st; v0 = a; v1 = b; }
        bf16_t* o = Q + (size_t)row * QFULL + col; st4bf(o, v0 * C2MLA); st4bf(o + 16, v1 * C2MLA); }
    __device__ __forceinline__ void post(const pg8::Unit&, int, int) const {}
};
struct F_Kvup {
    bf16_t* KV; const float* lstat;
    struct Ctx { int d; }; struct Ld { f32x4 a, b; }; typedef LdNone Row; static constexpr int PD = 1;
    __device__ __forceinline__ Row loadrow(const pg8::Unit&, int) const { Row r; r.d = 0; return r; }
    __device__ __forceinline__ Ctx prep(const pg8::Unit&, int) const { Ctx c; c.d = 0; return c; }
    __device__ __forceinline__ Ld load(const Ctx&, const pg8::Unit&, int row, int) const { Ld l; const float* ls = lstat + (size_t)row * 24 + 12; l.a = *(const GAS f32x4*)ls; l.b = *(const GAS f32x4*)(ls + 4); return l; }
    __device__ __forceinline__ void finish(const Ctx&, const pg8::Unit&, int row, int col, const Row&, const Ld& l, f32x4 v0, f32x4 v1, int) const {
        const f32x4 t = l.a + l.b; const float rs = 1.0f / sqrtf(((t[0] + t[1]) + (t[2] + t[3])) * (1.0f / KVRANK) + NORM_EPS);
        bf16_t* o = KV + (size_t)row * KVW + col; st4bf(o, v0 * rs); st4bf(o + 16, v1 * rs); }
    __device__ __forceinline__ void post(const pg8::Unit&, int, int) const {}
};
__device__ __forceinline__ f32x4 sigmoid4(f32x4 g) { f32x4 r;
#pragma unroll
    for (int i = 0; i < 4; ++i) r[i] = __builtin_amdgcn_rcpf(1.0f + __builtin_amdgcn_exp2f(-LOG2E * g[i]));
    return r; }
struct F_Gate {
    const bf16_t* P; bf16_t* Mg;
    struct Ctx { int goff; }; struct Ld { u32x2 g0, g1, m0, m1; }; typedef LdNone Row; static constexpr int PD = 2;
    __device__ __forceinline__ Row loadrow(const pg8::Unit&, int) const { Row r; r.d = 0; return r; }
    __device__ __forceinline__ Ctx prep(const pg8::Unit& u, int) const { Ctx c; c.goff = u.z ? C_GMLA : C_GSB; return c; }
    __device__ __forceinline__ Ld load(const Ctx& c, const pg8::Unit& u, int row, int col) const { Ld l; const bf16_t* gp = P + (size_t)row * NPJ + c.goff + col;
        l.g0 = *(const GAS u32x2*)gp; l.g1 = *(const GAS u32x2*)(gp + 16); l.m0 = l.g0; l.m1 = l.g1;
        if (u.z) { const bf16_t* o = Mg + (size_t)row * DM + col; l.m0 = *(const GAS u32x2*)o; l.m1 = *(const GAS u32x2*)(o + 16); } return l; }
    __device__ __forceinline__ void finish(const Ctx&, const pg8::Unit& u, int row, int col, const Row&, const Ld& l, f32x4 v0, f32x4 v1, int) const {
        bf16_t* o = Mg + (size_t)row * DM + col;
        f32x4 r0 = sigmoid4(bf4(l.g0)) * v0, r1 = sigmoid4(bf4(l.g1)) * v1;
        if (u.z) { r0 += bf4(l.m0); r1 += bf4(l.m1); }
        st4bf(o, r0); st4bf(o + 16, r1); }
    __device__ __forceinline__ void post(const pg8::Unit&, int, int) const {}
};
struct F_Resid {
    const float* base; float* X; const float* gate; const float* gn; const float* scn; bf16_t* XG; float* xstat; LAS float* part;
    struct Ctx { f32x4 g0, g1, m0, m1; int slot; }; struct Ld { f32x4 b0, b1; }; typedef LdNone Row; static constexpr int PD = 2;
    __device__ __forceinline__ Row loadrow(const pg8::Unit&, int) const { Row r; r.d = 0; return r; }
    __device__ __forceinline__ Ctx prep(const pg8::Unit& u, int col) const { Ctx c; const size_t bo = (size_t)(u.pm >> 3) * (6 * DM) + col; const float* gp = gate + bo; c.g0 = *(const GAS f32x4*)gp; c.g1 = *(const GAS f32x4*)(gp + 16);
        const float* sp = scn + bo; c.m0 = *(const GAS f32x4*)(gn + col) * (1.0f + *(const GAS f32x4*)sp); c.m1 = *(const GAS f32x4*)(gn + col + 16) * (1.0f + *(const GAS f32x4*)(sp + 16));
        c.slot = (col >> 5) & 7; return c; }
    __device__ __forceinline__ Ld load(const Ctx&, const pg8::Unit&, int row, int col) const { Ld l; const size_t off = (size_t)row * DM + col; l.b0 = *(const GAS f32x4*)(base + off); l.b1 = *(const GAS f32x4*)(base + off + 16); return l; }
    __device__ __forceinline__ void finish(const Ctx& c, const pg8::Unit&, int row, int col, const Row&, const Ld& l, f32x4 v0, f32x4 v1, int fq) const {
        const size_t off = (size_t)row * DM + col;
        const f32x4 x0 = l.b0 + c.g0 * v0, x1 = l.b1 + c.g1 * v1;
        *(GAS f32x4*)(X + off) = x0; *(GAS f32x4*)(X + off + 16) = x1;
        st4bf(XG + off, x0 * c.m0); st4bf(XG + off + 16, x1 * c.m1);
        const float ss = sum_fq(dot4(x0) + dot4(x1));
        if (fq == 0) part[(row & 255) * 8 + c.slot] = ss; }
    __device__ __forceinline__ void post(const pg8::Unit& u, int wave, int lane) const {
        asm volatile("s_waitcnt lgkmcnt(0)" ::: "memory"); __builtin_amdgcn_s_barrier(); asm volatile("" ::: "memory");
        if (wave < 4) { const int r = wave * 64 + lane; const LAS float* p = part + r * 8;
            ((GAS float*)xstat)[(size_t)(u.pm * 256 + r) * 4 + u.pn] = ((p[0] + p[1]) + (p[2] + p[3])) + ((p[4] + p[5]) + (p[6] + p[7])); }
        asm volatile("s_waitcnt lgkmcnt(0)" ::: "memory"); __builtin_amdgcn_s_barrier(); asm volatile("" ::: "memory");
    }
};
struct F_Sqrelu {
    bf16_t* U; const float* xstat; const float* sv;
    struct Ctx { f32x4 s0, s1; }; typedef LdNone Ld; struct Row { float rs; }; static constexpr int PD = 0;
    __device__ __forceinline__ Row loadrow(const pg8::Unit&, int row) const { const f32x4 xs = *(const GAS f32x4*)(xstat + (size_t)row * 4); Row r; r.rs = 1.0f / sqrtf(((xs[0] + xs[1]) + (xs[2] + xs[3])) * (1.0f / DM) + NORM_EPS); return r; }
    __device__ __forceinline__ Ctx prep(const pg8::Unit& u, int col) const { Ctx c; const float* sp = sv + (size_t)(u.pm >> 3) * FF + col; c.s0 = *(const GAS f32x4*)sp; c.s1 = *(const GAS f32x4*)(sp + 16); return c; }
    __device__ __forceinline__ Ld load(const Ctx&, const pg8::Unit&, int, int) const { Ld l; l.d = 0; return l; }
    __device__ __forceinline__ void finish(const Ctx& c, const pg8::Unit&, int row, int col, const Row& rw, const Ld&, f32x4 v0, f32x4 v1, int) const {
        const float rs = rw.rs;
        const f32x4 z = {0.f, 0.f, 0.f, 0.f};
        f32x4 a = __builtin_elementwise_max(v0 * rs + c.s0, z), b = __builtin_elementwise_max(v1 * rs + c.s1, z);
        bf16_t* o = U + (size_t)row * FF + col; st4bf(o, a * a); st4bf(o + 16, b * b); }
    __device__ __forceinline__ void post(const pg8::Unit&, int, int) const {}
};

struct EpiAll {
    int kind; unsigned char* ws; float* xo; const float* base; const float* gate; const float* gn; const float* scn; const float* sv; LAS float* part;
    template <class F> __device__ __forceinline__ void run(const F& f, const f32x4 (&acc)[2][2][4][2], const pg8::Unit& u, int wr, int wc) const { pg8::Epi<F> e{f}; e(acc, u, wr, wc, 0, 0); }
    __device__ __forceinline__ void operator()(const f32x4 (&acc)[2][2][4][2], const pg8::Unit& u, int wr, int wc, int, int) const {
        const float* cosT = (const float*)(ws + WS_COS); const float* sinT = (const float*)(ws + WS_SIN); float* xstat = (float*)(ws + WS_XSTAT); float* lstat = (float*)(ws + WS_LSTAT);
        if (kind == 0) run(F_ProjA{(bf16_t*)(ws + WS_P), xstat, sv, lstat, (bf16_t*)(ws + WS_KPE), cosT, sinT}, acc, u, wr, wc);
        else if (kind == 1) run(F_Qup{(bf16_t*)(ws + WS_QF), cosT, sinT, lstat}, acc, u, wr, wc);
        else if (kind == 2) run(F_Kvup{(bf16_t*)(ws + WS_KV), lstat}, acc, u, wr, wc);
        else if (kind == 3) run(F_Gate{(const bf16_t*)(ws + WS_P), (bf16_t*)(ws + WS_QF)}, acc, u, wr, wc);
        else if (kind == 4) run(F_Resid{base, xo, gate, gn, scn, (bf16_t*)(ws + WS_H), xstat, part}, acc, u, wr, wc);
        else run(F_Sqrelu{(bf16_t*)(ws + WS_P), xstat, sv}, acc, u, wr, wc);
    }
};

__device__ __forceinline__ int crow(int r, int hi) { return (r & 3) + 8 * (r >> 2) + 4 * hi; }
typedef short v4i16_t __attribute__((ext_vector_type(4)));
__device__ __forceinline__ s16x4 vtr(const LAS unsigned char* p) { return __builtin_bit_cast(s16x4, __builtin_amdgcn_ds_read_tr16_b64_v4i16((LAS v4i16_t*)p)); }

__device__ __forceinline__ float prod_halves(float v) { float a = v, b = v; swap32(a, b); return a * b; }
template <bool DIAG>
__device__ __forceinline__ void sb_half(const f32x16& y16, float& Rp, int kb, int tq, int hi, u32x4& pwa, u32x4& pwb) {
    float s[16], f[16];
#pragma unroll
    for (int r = 0; r < 16; ++r) {
        const float y = y16[r];
        const float e = __builtin_amdgcn_exp2f(-fabsf(y));
        const float rr = __builtin_amdgcn_rcpf(1.0f + e), er = e * rr;
        const bool pos = y >= 0.f;
        float sg = pos ? rr : er, fl = pos ? er : rr;
        if (DIAG) { const bool valid = (kb + crow(r, hi)) < tq; sg = valid ? sg : 0.f; fl = valid ? fl : 1.0f; }
        s[r] = sg; f[r] = fl;
    }
    float G[4], OS[4];
#pragma unroll
    for (int g = 0; g < 4; ++g) G[g] = (f[4 * g] * f[4 * g + 1]) * (f[4 * g + 2] * f[4 * g + 3]);
    OS[3] = G[3];
#pragma unroll
    for (int g = 2; g >= 0; --g) OS[g] = G[g] * OS[g + 1];
    const float T = prod_halves(OS[0]);
#pragma unroll
    for (int g = 0; g < 4; ++g) {
        const float ex = (g < 3) ? OS[g + 1] : 1.0f;
        const float snd = hi ? OS[g] : ex;
        const float rcv = other_half(snd, hi);
        float w = (Rp * ex) * rcv;
        const float a3 = s[4 * g + 3] * w; w *= f[4 * g + 3];
        const float a2 = s[4 * g + 2] * w; w *= f[4 * g + 2];
        const float a1 = s[4 * g + 1] * w; w *= f[4 * g + 1];
        const float a0 = s[4 * g] * w;
        const unsigned lo = cvtpk(a0, a1), up = cvtpk(a2, a3);
        if (g == 0) { pwa[0] = lo; pwa[1] = up; } else if (g == 1) { pwa[2] = lo; pwa[3] = up; } else if (g == 2) { pwb[0] = lo; pwb[1] = up; } else { pwb[2] = lo; pwb[3] = up; }
    }
    Rp *= T;
}
template <bool DIAG>
__device__ __forceinline__ float sm_weights(f32x16& p0, f32x16& p1, float& m, float& l, int kb, int tq, int hi, u32x4 (&pw)[4]) {
    if (DIAG) {
#pragma unroll
        for (int r = 0; r < 16; ++r) { const int key = kb + crow(r, hi); if (key > tq) p0[r] = -INFINITY; if (key + 32 > tq) p1[r] = -INFINITY; }
    }
    float mx = fmaxf(p0[0], p1[0]);
#pragma unroll
    for (int r = 1; r < 16; ++r) mx = fmaxf(mx, fmaxf(p0[r], p1[r]));
    mx = max_halves(mx);
    const float mn = (mx > m + 8.0f) ? mx : m, alpha = __builtin_amdgcn_exp2f(m - mn);
    m = mn;
    float sum = 0.f;
#pragma unroll
    for (int j = 0; j < 8; ++j) {
        const float a = __builtin_amdgcn_exp2f(p0[2 * j] - mn), b = __builtin_amdgcn_exp2f(p0[2 * j + 1] - mn), c = __builtin_amdgcn_exp2f(p1[2 * j] - mn), d = __builtin_amdgcn_exp2f(p1[2 * j + 1] - mn);
        sum += (a + b) + (c + d);
        pw[j >> 2][j & 3] = cvtpk(a, b); pw[2 + (j >> 2)][j & 3] = cvtpk(c, d);
    }
    l = l * alpha + sum;
    return alpha;
}

template <bool MLA>
__device__ __forceinline__ void attn_tile(const LAS unsigned char* Kb, const LAS unsigned char* Vb, const bf16x8 (&qr)[MLA ? 6 : 4], f32x16& o0, f32x16& o1, float& R, float& m_run, float& l_run,
                                          int kb, int tq, int hi, bool diag) {
    constexpr int NKS = MLA ? 6 : 4;
    u32x4 pw[4];
    if (MLA) {
        f32x16 p0, p1;
#pragma unroll
        for (int r = 0; r < 16; ++r) { p0[r] = 0.f; p1[r] = 0.f; }
#pragma unroll
        for (int ks = 0; ks < NKS; ++ks) {
            const bf16x8 k0 = *(const LAS bf16x8*)(Kb + ks * 2048), k1 = *(const LAS bf16x8*)(Kb + ks * 2048 + 512);
            p0 = MFMA32(k0, qr[ks], p0); p1 = MFMA32(k1, qr[ks], p1);
        }
        float alpha;
        if (diag) alpha = sm_weights<true>(p0, p1, m_run, l_run, kb, tq, hi, pw); else alpha = sm_weights<false>(p0, p1, m_run, l_run, kb, tq, hi, pw);
        if (__builtin_amdgcn_ballot_w64(alpha != 1.0f) != 0ull) {
#pragma unroll
            for (int r = 0; r < 16; ++r) { o0[r] *= alpha; o1[r] *= alpha; } }
    } else {
#pragma unroll
        for (int sub = 1; sub >= 0; --sub) {
            f32x16 p;
#pragma unroll
            for (int r = 0; r < 16; ++r) p[r] = 0.f;
#pragma unroll
            for (int ks = 0; ks < NKS; ++ks) { const bf16x8 kf = *(const LAS bf16x8*)(Kb + ks * 2048 + sub * 512); p = MFMA32(kf, qr[ks], p); }
            if (diag) sb_half<true>(p, R, kb + 32 * sub, tq, hi, pw[2 * sub], pw[2 * sub + 1]); else sb_half<false>(p, R, kb + 32 * sub, tq, hi, pw[2 * sub], pw[2 * sub + 1]);
        }
    }
#pragma unroll
    for (int ks = 0; ks < 4; ++ks) {
        const bf16x8 pa = __builtin_bit_cast(bf16x8, pw[ks]);
        const s16x4 a0 = vtr(Vb + ks * 1024), a1 = vtr(Vb + ks * 1024 + 512), c0 = vtr(Vb + 4096 + ks * 1024), c1 = vtr(Vb + 4096 + ks * 1024 + 512);
        const bf16x8 v0 = {a0[0], a0[1], a0[2], a0[3], a1[0], a1[1], a1[2], a1[3]}, v1 = {c0[0], c0[1], c0[2], c0[3], c1[0], c1[1], c1[2], c1[3]};
        o0 = MFMA32(v0, pa, o0); o1 = MFMA32(v1, pa, o1);
    }
}

struct AttnStage { u32x4 k, v, k2; };
template <bool MLA>
__device__ __forceinline__ void attn_unit(LAS unsigned char* lds, int tid, int b, int qb,
                                          const bf16_t* Qp, int qpitch, int qoff, const bf16_t* Kp, int kpitch, int koff, const bf16_t* KPE,
                                          const bf16_t* Vp, int vpitch, int voff, bf16_t* Op, int opitch, int ooff) {
    asm volatile("" : "+v"(tid));
    constexpr int NKS = MLA ? 6 : 4;
    constexpr int BUFB = 20480, VOFF = 12288;
    const int lane = tid & 63, r32 = lane & 31, hi = lane >> 5;
    const int wid = __builtin_amdgcn_readfirstlane(tid >> 6);
    const size_t rowbase = (size_t)b * SEQ;
    const int q0 = qb * 256, tq = q0 + wid * 32 + r32, nt = 4 * qb + 4, wlast = 4 * qb + (wid >> 1);
    bf16x8 qr[NKS];
    { const bf16_t* qrow = Qp + (rowbase + tq) * qpitch + qoff + hi * 8;
#pragma unroll
      for (int ks = 0; ks < NKS; ++ks) qr[ks] = *(const GAS bf16x8*)(qrow + ks * 16); }
    const bf16_t* ksrc = Kp + (rowbase + lane) * kpitch + koff + wid * 8;
    const bf16_t* k2src = KPE + (rowbase + lane) * 32 + (wid & 3) * 8;
    const bf16_t* vsrc = Vp + (rowbase + 16 * (wid & 3) + (lane >> 2)) * vpitch + voff + (wid >> 2) * 32 + (lane & 3) * 8;
    const int kdst = wid * 1024 + lane * 16, k2dst = (8 + (wid & 3)) * 1024 + lane * 16, vdst = VOFF + wid * 1024 + lane * 16;
    const int kfrag = hi * 1024 + r32 * 16;
    const int vfrag = VOFF + ((lane >> 4) & 1) * 32 + (lane & 3) * 8 + (4 * hi + ((lane & 15) >> 2)) * 64;
    f32x16 o0, o1;
#pragma unroll
    for (int r = 0; r < 16; ++r) { o0[r] = 0.f; o1[r] = 0.f; }
    float R = 1.0f, m_run = -INFINITY, l_run = 0.f;
    AttnStage RA, RB;
#define TILE_OF(i) (MLA ? (i) : (nt - 1 - (i)))
#define LOADT(S, kt) do { S.k = *(const GAS u32x4*)(ksrc + (size_t)(kt) * 64 * kpitch); S.v = *(const GAS u32x4*)(vsrc + (size_t)(kt) * 64 * vpitch); \
        if (MLA) S.k2 = *(const GAS u32x4*)(k2src + (size_t)(kt) * 64 * 32); } while (0)
#define WRITET(S, bo) do { *(LAS u32x4*)(lds + (bo) + kdst) = S.k; *(LAS u32x4*)(lds + (bo) + vdst) = S.v; \
        if (MLA && wid < 4) *(LAS u32x4*)(lds + (bo) + k2dst) = S.k2; } while (0)
    constexpr float SB_EXIT = 3.5527136788005009e-15f;
    volatile LAS unsigned* cnt = (volatile LAS unsigned*)(lds + 3 * BUFB);
    if (!MLA && tid == 0) { cnt[0] = 0u; cnt[1] = 0u; cnt[2] = 0u; }
    bool wdone = false, stop = false; int ci = 0, bcur = 0;
#define STEP(i_, SL, SW) do { const int i = (i_); const int kt = TILE_OF(i); const int cn = (ci == 2) ? 0 : ci + 1; const int bnext = (bcur == 2 * BUFB) ? 0 : bcur + BUFB; \
        if (!MLA && tid == 0) cnt[cn] = 0u; \
        if (i + 2 < nt) LOADT(SL, TILE_OF(i + 2)); \
        if (kt <= wlast && !wdone) { \
            attn_tile<MLA>(lds + bcur + kfrag, lds + bcur + vfrag, qr, o0, o1, R, m_run, l_run, kt * 64, tq, hi, kt == wlast); \
            if (!MLA) wdone = (__builtin_amdgcn_ballot_w64(R > SB_EXIT) == 0ull); } \
        if (!MLA && wdone && lane == 0) __hip_atomic_fetch_add((LAS unsigned*)(lds + 3 * BUFB) + ci, 1u, __ATOMIC_RELAXED, __HIP_MEMORY_SCOPE_WORKGROUP); \
        if (i + 1 < nt) WRITET(SW, bnext); \
        __syncthreads(); \
        if (!MLA) { if (cnt[ci] == (unsigned)NWAVES) stop = true; ci = cn; } \
        bcur = bnext; } while (0)
    LOADT(RA, TILE_OF(0)); WRITET(RA, 0); LOADT(RB, TILE_OF(1)); __syncthreads();
    for (int i2 = 0; i2 < nt; i2 += 2) {
        STEP(i2, RA, RB); if (stop) break;
        STEP(i2 + 1, RB, RA); if (stop) break;
    }
    if (!MLA) __syncthreads();
#undef STEP
#undef TILE_OF
#undef LOADT
#undef WRITET
    if (MLA) { const float lt = sum_halves(l_run); const float inv = 1.0f / lt;
#pragma unroll
        for (int r = 0; r < 16; ++r) { o0[r] *= inv; o1[r] *= inv; } }
    bf16_t* orow = Op + (rowbase + tq) * opitch + ooff + 4 * hi;
#pragma unroll
    for (int g = 0; g < 4; ++g) {
        st4bf(orow + 8 * g, (f32x4){o0[4 * g], o0[4 * g + 1], o0[4 * g + 2], o0[4 * g + 3]});
        st4bf(orow + 32 + 8 * g, (f32x4){o1[4 * g], o1[4 * g + 1], o1[4 * g + 2], o1[4 * g + 3]});
    }
}

typedef GAS unsigned gu32;
#define RLX_AGENT __ATOMIC_RELAXED, __HIP_MEMORY_SCOPE_AGENT
#define XB_TMO      128
#define XB_XCNT(j)  (256  + 64 * (j))
#define XB_XSUB(j)  (1280 + 64 * (j))
#define XB_XGEN(j)  (2304 + 64 * (j))
#define XB_TOP      3328
#define XB_TOPGEN   3392
#define XCD_BAR_WORDS 3456
#define XB_SPIN_CAP (1u << 18)
constexpr int CW_BAR = 4096;
constexpr int CW_QUEUE = 200000;
__device__ __forceinline__ unsigned xb_ld(unsigned* p)              { return __hip_atomic_load(p, __ATOMIC_RELAXED, __HIP_MEMORY_SCOPE_AGENT); }
__device__ __forceinline__ unsigned xb_add(unsigned* p, unsigned v) { return __hip_atomic_fetch_add(p, v, __ATOMIC_RELAXED, __HIP_MEMORY_SCOPE_AGENT); }
__device__ __forceinline__ unsigned xb_xcc_id() { return (unsigned)__builtin_amdgcn_s_getreg((3 << 11) | 20) & 0xFu; }
#define XB_SPIN(cond, bar) do { unsigned _sp = 0; while (cond) { __builtin_amdgcn_s_sleep(1); \
    if ((++_sp & 255u) == 0u) { if (xb_ld(&(bar)[XB_TMO])) break; if (_sp > XB_SPIN_CAP) { atomicAdd(&(bar)[XB_TMO], 1u); break; } } } } while (0)
struct XcdBarrier { unsigned* bar; unsigned x; volatile LAS unsigned* st; };
__device__ __forceinline__ XcdBarrier xcd_barrier_post(unsigned* bar, volatile LAS unsigned* st) {
    XcdBarrier b; b.bar = bar; b.x = xb_xcc_id(); b.st = st;
    if (threadIdx.x == 0) (void)xb_add(&bar[XB_XCNT(b.x)], 1u);
    return b;
}
__device__ __forceinline__ void xcd_barrier_complete(unsigned* bar, unsigned x, unsigned& nloc, unsigned& nx) {
    const unsigned G = gridDim.x * gridDim.y * gridDim.z;
    unsigned sum, cnt, mine, sp = 0u;
    for (;;) {
        sum = 0u; cnt = 0u; mine = 0u;
#pragma unroll 1
        for (unsigned j = 0; j < 16; ++j) { const unsigned c = xb_ld(&bar[XB_XCNT(j)]); sum += c; cnt += (c > 0u) ? 1u : 0u; mine = (j == x) ? c : mine; }
        if (sum == G) break;
        __builtin_amdgcn_s_sleep(1);
        if ((++sp & 255u) == 0u) { if (xb_ld(&bar[XB_TMO])) break; if (sp > XB_SPIN_CAP) { atomicAdd(&bar[XB_TMO], 1u); break; } }
    }
    nloc = mine > 0u ? mine : 1u; nx = cnt > 0u ? cnt : 1u;
}
__device__ __forceinline__ void xcd_barrier(const XcdBarrier& b) {
    asm volatile("s_waitcnt vmcnt(0)" ::: "memory");
    __syncthreads();
    if (threadIdx.x == 0) {
        unsigned* bar = b.bar;
        __builtin_amdgcn_s_waitcnt(0);
        unsigned nloc = b.st[0], nx = b.st[1];
        if (nloc == 0u) { xcd_barrier_complete(bar, b.x, nloc, nx); b.st[0] = nloc; b.st[1] = nx; }
        const unsigned old = xb_add(&bar[XB_XSUB(b.x)], 1u);
        const unsigned gen = old / nloc;
        if (old + 1u == (gen + 1u) * nloc) {
            __builtin_amdgcn_fence(__ATOMIC_RELEASE, "agent");
            asm volatile("s_waitcnt vmcnt(0)" ::: "memory");
            const unsigned og = xb_add(&bar[XB_TOP], 1u);
            const unsigned tg = og / nx;
            if (og + 1u == (tg + 1u) * nx) xb_add(&bar[XB_TOPGEN], 1u);
            else XB_SPIN(xb_ld(&bar[XB_TOPGEN]) == tg, bar);
            __builtin_amdgcn_fence(__ATOMIC_ACQUIRE, "agent");
            xb_add(&bar[XB_XGEN(b.x)], 1u);
            asm volatile("s_waitcnt vmcnt(0)" ::: "memory");
        } else {
            XB_SPIN(xb_ld(&bar[XB_XGEN(b.x)]) == gen, bar);
            __builtin_amdgcn_fence(__ATOMIC_ACQUIRE, "agent");
            asm volatile("s_waitcnt vmcnt(0)" ::: "memory");
        }
    }
    __syncthreads();
}

struct Args { const void* in[18]; float* out; unsigned char* ws; int ph_lo, ph_hi; };
struct Frame {
    LAS unsigned char* lds;
    int tid, lane, wave, vcu, G;
};
typedef const void* cvp_t;
__device__ __forceinline__ const void* arg_in(int i) { const __attribute__((address_space(4))) cvp_t* p = (const __attribute__((address_space(4))) cvp_t*)__builtin_amdgcn_kernarg_segment_ptr(); asm volatile("" : "+s"(p)); return p[i]; }

__device__ __forceinline__ void transpose_item(const float* W, int K, int N, bf16_t* WT, int thresh, int add, const float* gain, LAS float* scr, int item, int lane) {
    const int nblk = N / 32, kb = item / nblk, nb = item % nblk, k0 = 64 * kb, n0 = 32 * nb;
#pragma unroll 8
    for (int i = 0; i < 32; ++i) { const int kk = 2 * i + (lane >> 5); scr[kk * 33 + (lane & 31)] = ((const GAS float*)W)[(size_t)(k0 + kk) * N + n0 + (lane & 31)]; }
    LDS_WAIT(); asm volatile("" ::: "memory");
    const int c = lane & 7;
    float gv[8];
#pragma unroll
    for (int e = 0; e < 8; ++e) gv[e] = gain ? ((const GAS float*)gain)[k0 + 8 * c + e] : 1.0f;
    const int radd = (n0 >= thresh) ? add : 0;
#pragma unroll
    for (int j = 0; j < 4; ++j) { const int n = (lane >> 3) + 8 * j; const LAS float* s = scr + (8 * c) * 33 + n;
        u32x4 o; o.x = cvtpk(s[0 * 33] * gv[0], s[1 * 33] * gv[1]); o.y = cvtpk(s[2 * 33] * gv[2], s[3 * 33] * gv[3]); o.z = cvtpk(s[4 * 33] * gv[4], s[5 * 33] * gv[5]); o.w = cvtpk(s[6 * 33] * gv[6], s[7 * 33] * gv[7]);
        *(GAS u32x4*)(WT + (size_t)(radd + n0 + n) * K + k0 + 8 * c) = o; }
    LDS_WAIT(); asm volatile("" ::: "memory");
}

__device__ __forceinline__ void gemv8_item(const Frame& F, const LAS float* vec, LAS float* red, const float* W, int ldw, int n0, int nvalid, const float* bias, float* out, size_t ostride, int split, int add) {
    const int n = F.tid & 31, kc = F.tid >> 5; const bool ok = (n0 + n) < nvalid;
    const GAS float* w = (const GAS float*)W + (size_t)(kc * 64) * ldw + n0 + (ok ? n : 0);
    float acc[8];
#pragma unroll
    for (int b = 0; b < 8; ++b) acc[b] = 0.f;
#pragma unroll 1
    for (int k0 = 0; k0 < 64; k0 += 16) {
        float wv[16];
#pragma unroll
        for (int k = 0; k < 16; ++k) wv[k] = w[(size_t)(k0 + k) * ldw];
#pragma unroll
        for (int k = 0; k < 16; ++k)
#pragma unroll
            for (int b = 0; b < 8; ++b) acc[b] += wv[k] * vec[b * DM + kc * 64 + k0 + k];
    }
#pragma unroll
    for (int b = 0; b < 8; ++b) red[(kc * 8 + b) * 32 + n] = acc[b];
    __syncthreads();
    if (F.tid < 256) { const int b = F.tid >> 5; float s = (bias && ok) ? ((const GAS float*)bias)[n0 + n] : 0.f;
#pragma unroll
      for (int k2 = 0; k2 < 16; ++k2) s += red[(k2 * 8 + b) * 32 + n];
      if (ok) ((GAS float*)out)[(size_t)b * ostride + (n0 + n) + ((n0 + n) >= split ? add : 0)] = s; }
    __syncthreads();
}
__device__ __forceinline__ void phase_p0a(const Frame& F, unsigned char* ws) {
    const int gt = blockIdx.x * 512 + F.tid, NT = F.G * 512;
    { const int* pos = (const int*)arg_in(2); float* cosT = (float*)(ws + WS_COS); float* sinT = (float*)(ws + WS_SIN);
      for (int idx = gt; idx < MTOK * 16; idx += NT) { const int t = idx >> 4, i = idx & 15;
          const float inv = 1.0f / __builtin_amdgcn_exp2f((float)(2 * i) * (13.287712379549449f / 32.0f));
          const float ang = (float)((const GAS int*)pos)[t] * inv;
          double rev = (double)ang * 0.15915494309189535; rev -= __builtin_rint(rev);
          const float fr = (float)rev;
          ((GAS float*)cosT)[idx] = __builtin_amdgcn_cosf(fr); ((GAS float*)sinT)[idx] = __builtin_amdgcn_sinf(fr); } }
    { const float* c = (const float*)arg_in(1); LAS float* cact = (LAS float*)F.lds; LAS float* red = (LAS float*)(F.lds + 32768);
      for (int i = F.tid; i < NB * DM; i += 512) { const float v = ((const GAS float*)c)[i]; cact[i] = v / (1.0f + __expf(-v)); }
      __syncthreads();
      for (int item = blockIdx.x; item < DEPTH * 192; item += F.G) { const int l = item / 192, n0 = (item % 192) * 32;
          gemv8_item(F, cact, red, (const float*)arg_in(3) + (size_t)l * DM * (6 * DM), 6 * DM, n0, 6 * DM, (const float*)arg_in(4) + l * (6 * DM), (float*)(ws + WS_MODS) + (size_t)l * NB * (6 * DM), 6 * DM, 1 << 30, 0); } }
}
__device__ __forceinline__ void phase_p0b(const Frame& F, unsigned char* ws) {
    const int gt = blockIdx.x * 512 + F.tid, NT = F.G * 512;
    const float* mods = (const float*)(ws + WS_MODS);
    { LAS float* vec = (LAS float*)F.lds; LAS float* red = (LAS float*)(F.lds + 32768);
      constexpr int I1 = IN_NAT / 32, I2 = FF / 32;
      for (int item = blockIdx.x; item < DEPTH * (I1 + I2); item += F.G) {
          const int l = item / (I1 + I2), r = item % (I1 + I2); const bool up = r >= I1; const int part = up ? 3 : 0;
          for (int i = F.tid; i < NB * DM; i += 512) vec[i] = ((const GAS float*)mods)[((size_t)l * NB + (i >> 10)) * (6 * DM) + part * DM + (i & 1023)];
          __syncthreads();
          if (!up) { const int n0 = r * 32; gemv8_item(F, vec, red, (const float*)arg_in(6) + (size_t)l * DM * IN_NAT, IN_NAT, n0, IN_NAT, nullptr, (float*)(ws + WS_SV1) + (size_t)l * NB * NPJ, NPJ, IN_SPLIT, NPJ - IN_NAT); }
          else { const int n0 = (r - I1) * 32; gemv8_item(F, vec, red, (const float*)arg_in(15) + (size_t)l * DM * FF, FF, n0, FF, nullptr, (float*)(ws + WS_SV2) + (size_t)l * NB * FF, FF, 1 << 30, 0); }
      }
      for (int idx = gt; idx < DEPTH * NB * (C_GSB - IN_SPLIT); idx += NT) { const int c = idx % (C_GSB - IN_SPLIT), lb = idx / (C_GSB - IN_SPLIT); ((GAS float*)(ws + WS_SV1))[(size_t)lb * NPJ + IN_SPLIT + c] = 0.f; }
    }
    { LAS float* scr = (LAS float*)(F.lds + F.wave * 16384);
      const int gw = F.vcu * NWAVES + F.wave, NGW = F.G * NWAVES;
      constexpr int I_IN = (DM / 64) * (IN_NAT / 32), I_QUP = (QRANK / 64) * (QFULL / 32), I_KVUP = (KVRANK / 64) * (KVW / 32), I_SB = (512 / 64) * (DM / 32), I_MIX = (DM / 64) * (DM / 32),
                    I_UP = (DM / 64) * (FF / 32), I_DOWN = (FF / 64) * (DM / 32), I_LAYER = I_IN + I_QUP + I_KVUP + 2 * I_SB + I_MIX + I_UP + I_DOWN;
      for (int it = gw; it < DEPTH * I_LAYER; it += NGW) {
          const int l = it / I_LAYER; int r = it % I_LAYER;
          unsigned char* wl = ws + WS_W + (size_t)l * LAYER_W;
          if (r < I_IN) { transpose_item((const float*)arg_in(6) + (size_t)l * DM * IN_NAT, DM, IN_NAT, (bf16_t*)(wl + OW_IN), IN_SPLIT, NPJ - IN_NAT, nullptr, scr, r, F.lane); continue; } r -= I_IN;
          if (r < I_QUP) { transpose_item((const float*)arg_in(8) + (size_t)l * QRANK * QFULL, QRANK, QFULL, (bf16_t*)(wl + OW_QUP), 1 << 30, 0, (const float*)arg_in(7) + l * QRANK, scr, r, F.lane); continue; } r -= I_QUP;
          if (r < I_KVUP) { transpose_item((const float*)arg_in(10) + (size_t)l * KVRANK * KVW, KVRANK, KVW, (bf16_t*)(wl + OW_KVUP), 1 << 30, 0, (const float*)arg_in(9) + l * KVRANK, scr, r, F.lane); continue; } r -= I_KVUP;
          if (r < I_SB) { transpose_item((const float*)arg_in(11) + (size_t)l * 512 * DM, 512, DM, (bf16_t*)(wl + OW_SB), 1 << 30, 0, nullptr, scr, r, F.lane); continue; } r -= I_SB;
          if (r < I_SB) { transpose_item((const float*)arg_in(12) + (size_t)l * 512 * DM, 512, DM, (bf16_t*)(wl + OW_MLA), 1 << 30, 0, nullptr, scr, r, F.lane); continue; } r -= I_SB;
          if (r < I_MIX) { transpose_item((const float*)arg_in(13) + (size_t)l * DM * DM, DM, DM, (bf16_t*)(wl + OW_MIX), 1 << 30, 0, nullptr, scr, r, F.lane); continue; } r -= I_MIX;
          if (r < I_UP) { transpose_item((const float*)arg_in(15) + (size_t)l * DM * FF, DM, FF, (bf16_t*)(wl + OW_UP), 1 << 30, 0, nullptr, scr, r, F.lane); continue; } r -= I_UP;
          transpose_item((const float*)arg_in(16) + (size_t)l * FF * DM, FF, DM, (bf16_t*)(wl + OW_DOWN), 1 << 30, 0, nullptr, scr, r, F.lane);
      }
      constexpr int ZV = (C_GSB - IN_SPLIT) * DM * 2 / 16;
      unsigned zu = 0u; asm volatile("" : "+v"(zu));
      for (int idx = gt; idx < DEPTH * ZV; idx += NT) { const int l = idx / ZV, r = idx % ZV;
          *(GAS u32x4*)(ws + WS_W + (size_t)l * LAYER_W + OW_IN + (size_t)IN_SPLIT * DM * 2 + (size_t)r * 16) = (u32x4){zu, zu, zu, zu}; }
      const float* x = (const float*)arg_in(0); const float* g = (const float*)arg_in(5);
      for (int m = gw; m < MTOK; m += NGW) {
          const GAS f32x4* xr = (const GAS f32x4*)(x + (size_t)m * DM) + F.lane;
          const float* sc = mods + (size_t)(m >> 11) * (6 * DM) + DM;
          float ss = 0.f;
#pragma unroll
          for (int j = 0; j < 4; ++j) { const int c = 4 * F.lane + 256 * j; const f32x4 v = xr[64 * j]; ss += dot4(v);
              st4bf((bf16_t*)(ws + WS_H) + (size_t)m * DM + c, v * (*(const GAS f32x4*)(g + c) * (1.0f + *(const GAS f32x4*)(sc + c)))); }
          ss = wave_sum(ss);
          if (F.lane == 0) *(GAS f32x4*)(ws + WS_XSTAT + (size_t)m * 16) = (f32x4){ss, 0.f, 0.f, 0.f};
      }
    }
}

__device__ __forceinline__ void phase_final(const Frame& F, float* X, const float* g) {
    const int gw = F.vcu * NWAVES + F.wave, NGW = F.G * NWAVES;
    for (int m = gw; m < MTOK; m += NGW) {
        GAS f32x4* xr = (GAS f32x4*)(X + (size_t)m * DM) + F.lane;
        f32x4 v[4]; float ss = 0.f;
#pragma unroll
        for (int j = 0; j < 4; ++j) { v[j] = xr[64 * j]; ss += (v[j][0] * v[j][0] + v[j][1] * v[j][1]) + (v[j][2] * v[j][2] + v[j][3] * v[j][3]); }
        const float rs = 1.0f / sqrtf(wave_sum(ss) * (1.0f / DM) + NORM_EPS);
#pragma unroll
        for (int j = 0; j < 4; ++j) xr[64 * j] = (v[j] * rs) * *(const GAS f32x4*)(g + 4 * F.lane + 256 * j);
    }
}

constexpr int STEPS = 8;
constexpr int N_PHASES = 3 + STEPS * DEPTH;

__global__ void __launch_bounds__(NWAVES * 64, 2) mk_fwd(Args a) {
    extern __shared__ __attribute__((aligned(16))) unsigned char lds_raw[];
    Frame F;
    F.lds = (LAS unsigned char*)lds_raw;
    F.tid = threadIdx.x; F.lane = F.tid & 63; F.wave = __builtin_amdgcn_readfirstlane(F.tid >> 6);
    F.G = gridDim.x; { const int bx = blockIdx.x; F.vcu = (F.G % 8 == 0) ? (bx % 8) * (F.G / 8) + bx / 8 : bx; }
    unsigned char* ws0 = a.ws;
    volatile LAS unsigned* MISC = (volatile LAS unsigned*)(F.lds + MISC_OFF);
    for (int u = F.tid; u < (LDS_BYTES - LDSCTL_OFF) / 4; u += NWAVES * 64) ((LAS unsigned*)(F.lds + LDSCTL_OFF))[u] = 0u;
    __syncthreads();
    const int lo = a.ph_lo, hi = a.ph_hi;
    XcdBarrier bar; bar.bar = (unsigned*)(ws0 + WS_CTL) + CW_BAR; bar.x = 0; bar.st = nullptr;
    if (hi - lo > 1) bar = xcd_barrier_post((unsigned*)(ws0 + WS_CTL) + CW_BAR, MISC + 8);

#define cosT ((const float*)(ws + WS_COS))
#define sinT ((const float*)(ws + WS_SIN))
#define P    ((bf16_t*)(ws + WS_P))
#define U    ((bf16_t*)(ws + WS_P))
#define QF   ((bf16_t*)(ws + WS_QF))
#define KV   ((bf16_t*)(ws + WS_KV))
#define MG   ((bf16_t*)(ws + WS_QF))
#define KPE  ((bf16_t*)(ws + WS_KPE))
#define H    ((bf16_t*)(ws + WS_H))
#define OSB  ((bf16_t*)(ws + WS_H))
#define OMLA ((bf16_t*)(ws + WS_H) + (size_t)MTOK * 512)
#define X    (a.out)
#define wl (ws + WS_W + (size_t)l * LAYER_W)
#define mods_l ((const float*)(ws + WS_MODS) + (size_t)l * NB * (6 * DM))
#define xin ((l == 0) ? (const float*)arg_in(0) : (const float*)X)

#define REFRESH() { unsigned z_ = 0u; asm volatile("" : "+v"(z_)); const int l_ = (int)__builtin_amdgcn_mbcnt_hi(~0u, __builtin_amdgcn_mbcnt_lo(~0u, z_)); F.lane = l_; F.tid = F.wave * 64 + l_; }
#define FRESH() int bx_; unsigned char* ws; { unsigned z_ = 0u; asm volatile("" : "+v"(z_)); const int l_ = (int)__builtin_amdgcn_mbcnt_hi(~0u, __builtin_amdgcn_mbcnt_lo(~0u, z_)); F.lane = l_; F.tid = F.wave * 64 + l_; \
        bx_ = blockIdx.x; asm volatile("" : "+s"(bx_)); ws = ws0; asm volatile("" : "+s"(ws)); { int g_ = gridDim.x; asm volatile("" : "+s"(g_)); F.G = g_; } }
#ifndef DUP_MASK
#define DUP_MASK 0
#endif
    for (int ph = lo; ph < hi; ++ph) {
        const int l = (ph - 2) / STEPS, t = (ph == 0) ? -1 : (ph == 1) ? -3 : (ph == N_PHASES - 1) ? -2 : (ph - 2) % STEPS;
        bool skip_bar = false;
        for (int rep = (DUP_MASK && t >= 0 && ((DUP_MASK >> t) & 1)) ? 0 : 1; rep < 2; ++rep) {
        if (DUP_MASK && rep == 1 && t >= 0 && ((DUP_MASK >> t) & 1)) xcd_barrier(bar);
        if (t == -1) {
            FRESH(); (void)bx_;
            phase_p0a(F, ws);
        } else if (t == -3) {
            FRESH(); (void)bx_;
            phase_p0b(F, ws);
        } else if (t == -2) {
            FRESH(); (void)bx_; (void)ws;
            phase_final(F, X, (const float*)arg_in(17));
        } else if (t == 3) {
            FRESH(); (void)bx_;
            {
                volatile LAS unsigned* qslot = (volatile LAS unsigned*)(F.lds + LDSCTL_OFF + 512);
                unsigned* qctr = (unsigned*)(ws + WS_CTL) + CW_QUEUE + 64 * (l * 2 + rep);
                for (;;) {
                    if (F.tid == 0) qslot[0] = __hip_atomic_fetch_add(qctr, 1u, __ATOMIC_RELAXED, __HIP_MEMORY_SCOPE_AGENT);
                    __syncthreads();
                    const int idx = (int)qslot[0];
                    __syncthreads();
                    if (idx >= 1024) break;
                    const int j = idx & 511, qb = 7 - (j >> 6), bh = j & 63, b = bh >> 3, h = bh & 7;
                    if (idx < 512) attn_unit<true>(F.lds, F.tid, b, qb, QF, QFULL, h * 96, KV, KVW, h * 128, KPE, KV, KVW, h * 128 + 64, OMLA, 512, h * 64);
                    else attn_unit<false>(F.lds, F.tid, b, qb, P, NPJ, C_QSB + h * 64, P, NPJ, C_KSB + h * 64, KPE, P, NPJ, C_VSB + h * 64, OSB, 512, h * 64);
                }
            }
        } else {
            FRESH();
            pg8::Gemm g; pg8::Order S; EpiAll E; int N = DM, crot = 0;
            g.A2 = nullptr; g.Bt2 = nullptr; S.pair = 0;
            E.ws = ws; E.xo = X; E.base = nullptr; E.gate = nullptr; E.gn = nullptr; E.scn = nullptr; E.sv = nullptr; E.part = (LAS float*)(F.lds + LDSCTL_OFF + 1024);
            if (t == 0) {
                g.A = H; g.Bt = (const bf16_t*)(wl + OW_IN); g.lda = DM; g.ldb = DM; g.K = DM; N = NPJ; E.kind = 0; E.sv = (const float*)(ws + WS_SV1) + (size_t)l * NB * NPJ;
            } else if (t == 1) {
                g.A = P + C_QLAT; g.Bt = (const bf16_t*)(wl + OW_QUP); g.lda = NPJ; g.ldb = QRANK; g.K = QRANK; N = QFULL; E.kind = 1; skip_bar = true;
            } else if (t == 2) {
                g.A = P + C_KVLAT; g.Bt = (const bf16_t*)(wl + OW_KVUP); g.lda = NPJ; g.ldb = KVRANK; g.K = KVRANK; N = KVW; E.kind = 2; crot = 192;
            } else if (t == 4) {
                g.A = OSB; g.Bt = (const bf16_t*)(wl + OW_SB); g.A2 = OMLA; g.Bt2 = (const bf16_t*)(wl + OW_MLA); g.lda = 512; g.ldb = 512; g.K = 512; S.pair = 1; E.kind = 3;
            } else if (t == 6) {
                g.A = H; g.Bt = (const bf16_t*)(wl + OW_UP); g.lda = DM; g.ldb = DM; g.K = DM; N = FF; E.kind = 5; E.sv = (const float*)(ws + WS_SV2) + (size_t)l * NB * FF;
            } else {
                const bool isF = (t == 7);
                g.A = isF ? U : MG; g.Bt = (const bf16_t*)(wl + (isF ? OW_DOWN : OW_MIX)); g.lda = isF ? FF : DM; g.ldb = g.lda; g.K = g.lda;
                E.kind = 4; E.base = isF ? (const float*)X : xin; E.gate = mods_l + (isF ? 5 : 2) * DM;
                const int ln = isF ? ((l + 1 < DEPTH) ? l + 1 : l) : l;
                E.gn = (const float*)arg_in(isF ? 5 : 14) + ln * DM; E.scn = (const float*)(ws + WS_MODS) + (size_t)ln * NB * (6 * DM) + (isF ? 1 : 4) * DM;
            }
            S.s.init(MTOK, N, F.G, (int)(((unsigned)bx_ + (unsigned)crot) % (unsigned)F.G));
            pg8::gemm_phase<EpiAll, pg8::Order, true>(F.lds, F.tid, g, S, E);
        }
        }
        if (ph + 1 < hi && !skip_bar) xcd_barrier(bar);
    }
}

extern "C" void kernel_launch(void* const* d_in, const int* in_sizes, int n_in, void* d_out, int out_size, void* d_ws, size_t ws_size, hipStream_t stream) {
    static int grid = 0;
    if (grid == 0) {
        if (n_in != 18 || in_sizes[0] != MTOK * DM || out_size != MTOK * DM || ws_size < WS_END) {
            fprintf(stderr, "kernel_launch: unexpected shapes (n_in %d, in0 %d, out %d, ws %zu); nothing launched\n", n_in, n_in > 0 ? in_sizes[0] : -1, out_size, ws_size); grid = -1; return; }
        int dev = 0, cus = 0, per_cu = 0;
        if (hipGetDevice(&dev) != hipSuccess || hipDeviceGetAttribute(&cus, hipDeviceAttributeMultiprocessorCount, dev) != hipSuccess) { grid = -1; return; }
        if (hipFuncSetAttribute((const void*)mk_fwd, hipFuncAttributeMaxDynamicSharedMemorySize, LDS_BYTES) != hipSuccess) { fprintf(stderr, "kernel_launch: hipFuncSetAttribute failed\n"); grid = -1; return; }
        if (hipOccupancyMaxActiveBlocksPerMultiprocessor(&per_cu, (const void*)mk_fwd, NWAVES * 64, LDS_BYTES) != hipSuccess || per_cu < 1) {
            fprintf(stderr, "kernel_launch: occupancy query reports %d workgroups per CU; nothing launched\n", per_cu); (void)hipGetLastError(); grid = -1; return; }
        grid = cus;
    }
    if (grid < 0) return;
    (void)hipMemsetAsync((char*)d_ws + WS_CTL, 0, CTL_ZERO_BYTES, stream);
    Args a{};
    for (int i = 0; i < 18; ++i) a.in[i] = d_in[i];
    a.out = (float*)d_out; a.ws = (unsigned char*)d_ws;
#if MK_N_LAUNCHES == 1
    a.ph_lo = 0; a.ph_hi = N_PHASES;
    void* kargs[] = {&a};
    hipError_t e = hipLaunchCooperativeKernel((const void*)mk_fwd, dim3(grid), dim3(NWAVES * 64), kargs, LDS_BYTES, stream);
    if (e != hipSuccess) fprintf(stderr, "kernel_launch: cooperative launch failed: %s (grid %d)\n", hipGetErrorString(e), grid);
#else
    for (int ph = 0; ph < N_PHASES; ++ph) {
        a.ph_lo = ph; a.ph_hi = ph + 1;
        hipLaunchKernelGGL(mk_fwd, dim3(grid), dim3(NWAVES * 64), LDS_BYTES, stream, a);
    }
#endif
}
```
